# Optimizing an MI355X kernel written in HIP

```python
import jax, jax.numpy as jnp
from jax import lax
import numpy as np


D_MODEL = 1024
BATCH = 16
SEQ = 2048
DEPTH = 2

CHUNK = 64
Q_BLOCK = 128
D_MIX = D_MODEL
EPS = 1e-6
N_MOD = 6

GDN_HEADS = 4
GDN_DK = D_MIX // 4 // GDN_HEADS
GDN_DV = D_MIX // 4 // GDN_HEADS
GDN_QK = GDN_HEADS * GDN_DK
GDN_VW = GDN_HEADS * GDN_DV
GDN_CONV = 4

RG_WIDTH = D_MIX // 2
RG_BLOCKS = 8
RG_BLOCK = RG_WIDTH // RG_BLOCKS
RG_CONV = 4
RG_C = 8.0

MLA_HEADS = 4
MLA_NOPE = 64
MLA_ROPE = 32
MLA_V = D_MIX // 4 // MLA_HEADS
MLA_Q_RANK = D_MODEL // 4
MLA_KV_RANK = D_MODEL // 8
ROPE_THETA = 10000.0

D_FF = 4 * D_MODEL

IN_SIZES = (GDN_QK, GDN_QK, GDN_VW, GDN_VW, GDN_HEADS, GDN_HEADS,
            RG_WIDTH, RG_WIDTH,
            MLA_Q_RANK, MLA_KV_RANK, MLA_ROPE)
D_IN = sum(IN_SIZES)

kernel_name = 'hybrid_gdn_rglru_mla_adaln_encoder'


def rmsnorm(x, g):
    xf = x.astype(jnp.float32)
    y = xf * lax.rsqrt(jnp.mean(xf * xf, axis=-1, keepdims=True) + EPS)
    return (y * g.astype(jnp.float32)).astype(x.dtype)


def l2norm(x):
    return x * lax.rsqrt(jnp.sum(x * x, axis=-1, keepdims=True) + EPS)


def causal_depthwise_conv(x, w):
    width = w.shape[0]
    return lax.conv_general_dilated(
        x, w[:, None, :].astype(x.dtype), window_strides=(1,),
        padding=[(width - 1, 0)], dimension_numbers=('NWC', 'WIO', 'NWC'),
        feature_group_count=x.shape[-1])


def gated_delta_rule(q, k, v, g, beta):
    bsz, seq, heads, dk = q.shape
    dv = v.shape[-1]
    n = seq // CHUNK

    def to_chunks(t):
        t = t.reshape((bsz, n, CHUNK) + t.shape[2:])
        return jnp.moveaxis(t, 3, 1)

    q, k, v, g, beta = (to_chunks(t) for t in (q, k, v, g, beta))
    q = q * (dk ** -0.5)
    g = jnp.cumsum(g, axis=-1)
    k_beta = k * beta[..., None]
    v_beta = v * beta[..., None]
    lower_incl = jnp.tril(jnp.ones((CHUNK, CHUNK), bool))
    strict_lower = jnp.tril(jnp.ones((CHUNK, CHUNK), bool), -1)
    diff = g[..., :, None] - g[..., None, :]
    decay = jnp.where(lower_incl, jnp.exp(jnp.where(lower_incl, diff, 0.0)), 0.0)
    lmat = jnp.where(strict_lower, jnp.einsum('bhncd,bhnsd->bhncs', k_beta, k) * decay, 0.0)
    tmat = jnp.eye(CHUNK, dtype=lmat.dtype) + lmat
    u = lax.linalg.triangular_solve(tmat, v_beta, left_side=True, lower=True)
    w = lax.linalg.triangular_solve(tmat, k_beta * jnp.exp(g)[..., None], left_side=True, lower=True)
    qk = jnp.einsum('bhncd,bhnsd->bhncs', q, k) * decay
    q_decay = q * jnp.exp(g)[..., None]
    k_tail = k * jnp.exp(g[..., -1:] - g)[..., None]
    chunk_decay = jnp.exp(g[..., -1])

    def step(state, xs):
        qk_c, qd_c, u_c, w_c, kt_c, cd_c = xs
        v_new = u_c - jnp.einsum('bhcd,bhde->bhce', w_c, state)
        o = jnp.einsum('bhcd,bhde->bhce', qd_c, state) + jnp.einsum('bhcs,bhse->bhce', qk_c, v_new)
        state = state * cd_c[..., None, None] + jnp.einsum('bhcd,bhce->bhde', kt_c, v_new)
        return state, o

    xs = tuple(jnp.moveaxis(t, 2, 0) for t in (qk, q_decay, u, w, k_tail, chunk_decay))
    s0 = jnp.zeros((bsz, heads, dk, dv), jnp.float32)
    _, o = lax.scan(step, s0, xs)
    o = jnp.moveaxis(o, 0, 2)
    return jnp.moveaxis(o, 1, 3).reshape(bsz, seq, heads, dv)


def gdn_mixer(q, k, v, z, a, b, conv_w, a_log, dt_bias, norm_g):
    dtype = q.dtype
    bsz, seq, _ = q.shape
    qkv = jax.nn.silu(causal_depthwise_conv(jnp.concatenate([q, k, v], axis=-1), conv_w))
    qkv = qkv.astype(jnp.float32)
    q, k, v = jnp.split(qkv, [GDN_QK, 2 * GDN_QK], axis=-1)
    q = l2norm(q.reshape(bsz, seq, GDN_HEADS, GDN_DK))
    k = l2norm(k.reshape(bsz, seq, GDN_HEADS, GDN_DK))
    v = v.reshape(bsz, seq, GDN_HEADS, GDN_DV)
    g = -jnp.exp(a_log.astype(jnp.float32)) * jax.nn.softplus(a.astype(jnp.float32) + dt_bias.astype(jnp.float32))
    beta = jax.nn.sigmoid(b.astype(jnp.float32))
    o = gated_delta_rule(q, k, v, g, beta)
    zg = jax.nn.silu(z.astype(jnp.float32).reshape(bsz, seq, GDN_HEADS, GDN_DV))
    o = rmsnorm(o, norm_g) * zg
    return o.reshape(bsz, seq, GDN_VW).astype(dtype)


def rglru_mixer(xb, gate, conv_w, conv_b, w_a, b_a, w_x, b_x, lam):
    dtype = xb.dtype
    bsz, seq, _ = xb.shape
    xc = causal_depthwise_conv(xb, conv_w) + conv_b
    xblk = xc.reshape(bsz, seq, RG_BLOCKS, RG_BLOCK)
    r = jax.nn.sigmoid(jnp.einsum('bsgi,gij->bsgj', xblk, w_a).reshape(bsz, seq, RG_WIDTH) + b_a)
    i = jax.nn.sigmoid(jnp.einsum('bsgi,gij->bsgj', xblk, w_x).reshape(bsz, seq, RG_WIDTH) + b_x)
    log_a = -RG_C * r.astype(jnp.float32) * jax.nn.softplus(-lam.astype(jnp.float32))
    a = jnp.exp(log_a)
    mult = jnp.sqrt(-jnp.expm1(2.0 * log_a))
    bterm = mult * (i * xc).astype(jnp.float32)

    def combine(left, right):
        a1, b1 = left
        a2, b2 = right
        return a1 * a2, a2 * b1 + b2

    _, h = lax.associative_scan(combine, (a, bterm), axis=1)
    return (h * jax.nn.gelu(gate.astype(jnp.float32))).astype(dtype)


def rope(x, cos, sin):
    x1, x2 = jnp.split(x, 2, axis=-1)
    return jnp.concatenate([x1 * cos - x2 * sin, x2 * cos + x1 * sin], axis=-1)


def mla_mixer(q_lat, kv_lat, k_rope, positions, q_norm_g, w_qb, kv_norm_g, w_kvb):
    dtype = q_lat.dtype
    bsz, seq, _ = q_lat.shape
    q = (rmsnorm(q_lat, q_norm_g) @ w_qb).reshape(bsz, seq, MLA_HEADS, MLA_NOPE + MLA_ROPE)
    q_nope, q_pe = jnp.split(q.astype(jnp.float32), [MLA_NOPE], axis=-1)
    kv = (rmsnorm(kv_lat, kv_norm_g) @ w_kvb).reshape(bsz, seq, MLA_HEADS, MLA_NOPE + MLA_V)
    k_nope, v = jnp.split(kv.astype(jnp.float32), [MLA_NOPE], axis=-1)
    inv_freq = ROPE_THETA ** (-jnp.arange(0, MLA_ROPE, 2, dtype=jnp.float32) / MLA_ROPE)
    ang = positions.astype(jnp.float32)[..., None] * inv_freq
    cos = jnp.cos(ang)[:, :, None, :]
    sin = jnp.sin(ang)[:, :, None, :]
    q_pe = rope(q_pe, cos, sin)
    k_pe = rope(k_rope.astype(jnp.float32)[:, :, None, :], cos, sin)[:, :, 0]
    scale = (MLA_NOPE + MLA_ROPE) ** -0.5
    chunk_id = jnp.arange(seq) // CHUNK
    outs = []
    for blk in range(seq // Q_BLOCK):
        q0, q1 = blk * Q_BLOCK, (blk + 1) * Q_BLOCK
        s = (jnp.einsum('bqhd,bkhd->bhqk', q_nope[:, q0:q1], k_nope[:, :q1])
             + jnp.einsum('bqhr,bkr->bhqk', q_pe[:, q0:q1], k_pe[:, :q1])) * scale
        mask = chunk_id[None, :q1] <= chunk_id[q0:q1, None]
        p = jax.nn.softmax(jnp.where(mask, s, -jnp.inf), axis=-1)
        outs.append(jnp.einsum('bhqk,bkhd->bqhd', p, v[:, :q1]))
    o = jnp.concatenate(outs, axis=1)
    return o.reshape(bsz, seq, MLA_HEADS * MLA_V).astype(dtype)


def setup_inputs(seed: int = 0) -> dict:
    key = jax.random.key(seed)
    ks = jax.random.split(key, 32)
    f32 = jnp.float32
    nrm = lambda k, shape, s: jax.random.normal(k, shape, f32) * s
    x = jax.random.normal(ks[0], (BATCH, SEQ, D_MODEL), f32)
    c = jax.random.normal(ks[1], (BATCH, D_MODEL), f32)
    offsets = jax.random.randint(ks[2], (BATCH, 1), 0, 4096, dtype=jnp.int32)
    positions = offsets + jnp.arange(SEQ, dtype=jnp.int32)[None, :]
    w_mod = nrm(ks[3], (DEPTH, D_MODEL, N_MOD * D_MODEL), 0.5 * D_MODEL ** -0.5)
    b_mod = nrm(ks[4], (DEPTH, N_MOD * D_MODEL), 0.02)
    norm_mix_g = 1.0 + nrm(ks[5], (DEPTH, D_MODEL), 0.02)
    w_in = nrm(ks[6], (DEPTH, D_MODEL, D_IN), D_MODEL ** -0.5)
    gdn_conv_w = nrm(ks[7], (DEPTH, GDN_CONV, 2 * GDN_QK + GDN_VW), GDN_CONV ** -0.5)
    gdn_a_log = jnp.log(jax.random.uniform(ks[8], (DEPTH, GDN_HEADS), f32, 1.0, 16.0))
    dt = jnp.exp(jax.random.uniform(ks[9], (DEPTH, GDN_HEADS), f32, np.log(1e-3), np.log(1e-1)))
    gdn_dt_bias = dt + jnp.log(-jnp.expm1(-dt))
    gdn_norm_g = 1.0 + nrm(ks[10], (DEPTH, GDN_DV), 0.02)
    rg_conv_w = nrm(ks[11], (DEPTH, RG_CONV, RG_WIDTH), RG_CONV ** -0.5)
    rg_conv_b = nrm(ks[12], (DEPTH, RG_WIDTH), 0.02)
    rg_w_a = nrm(ks[13], (DEPTH, RG_BLOCKS, RG_BLOCK, RG_BLOCK), RG_BLOCK ** -0.5)
    rg_b_a = nrm(ks[14], (DEPTH, RG_WIDTH), 0.02)
    rg_w_x = nrm(ks[15], (DEPTH, RG_BLOCKS, RG_BLOCK, RG_BLOCK), RG_BLOCK ** -0.5)
    rg_b_x = nrm(ks[16], (DEPTH, RG_WIDTH), 0.02)
    a0 = jax.random.uniform(ks[17], (DEPTH, RG_WIDTH), f32, 0.9, 0.999) ** (1.0 / RG_C)
    rg_lambda = jnp.log(a0) - jnp.log1p(-a0)
    mla_q_norm_g = 1.0 + nrm(ks[18], (DEPTH, MLA_Q_RANK), 0.02)
    mla_w_qb = nrm(ks[19], (DEPTH, MLA_Q_RANK, MLA_HEADS * (MLA_NOPE + MLA_ROPE)), MLA_Q_RANK ** -0.5)
    mla_kv_norm_g = 1.0 + nrm(ks[20], (DEPTH, MLA_KV_RANK), 0.02)
    mla_w_kvb = nrm(ks[21], (DEPTH, MLA_KV_RANK, MLA_HEADS * (MLA_NOPE + MLA_V)), MLA_KV_RANK ** -0.5)
    w_out = nrm(ks[22], (DEPTH, D_MIX, D_MODEL), D_MIX ** -0.5)
    norm_mlp_g = 1.0 + nrm(ks[23], (DEPTH, D_MODEL), 0.02)
    w_mlp_in = nrm(ks[24], (DEPTH, D_MODEL, D_FF), D_MODEL ** -0.5)
    w_mlp_out = nrm(ks[25], (DEPTH, D_FF, D_MODEL), D_FF ** -0.5)
    final_norm_g = 1.0 + nrm(ks[26], (D_MODEL,), 0.02)
    return {'x': x, 'c': c, 'positions': positions, 'w_mod': w_mod, 'b_mod': b_mod,
            'norm_mix_g': norm_mix_g, 'w_in': w_in, 'gdn_conv_w': gdn_conv_w,
            'gdn_a_log': gdn_a_log, 'gdn_dt_bias': gdn_dt_bias, 'gdn_norm_g': gdn_norm_g,
            'rg_conv_w': rg_conv_w, 'rg_conv_b': rg_conv_b, 'rg_w_a': rg_w_a, 'rg_b_a': rg_b_a,
            'rg_w_x': rg_w_x, 'rg_b_x': rg_b_x, 'rg_lambda': rg_lambda,
            'mla_q_norm_g': mla_q_norm_g, 'mla_w_qb': mla_w_qb, 'mla_kv_norm_g': mla_kv_norm_g,
            'mla_w_kvb': mla_w_kvb, 'w_out': w_out, 'norm_mlp_g': norm_mlp_g,
            'w_mlp_in': w_mlp_in, 'w_mlp_out': w_mlp_out, 'final_norm_g': final_norm_g}


def reference(x, c, positions, w_mod, b_mod, norm_mix_g, w_in, gdn_conv_w, gdn_a_log, gdn_dt_bias,
              gdn_norm_g, rg_conv_w, rg_conv_b, rg_w_a, rg_b_a, rg_w_x, rg_b_x, rg_lambda,
              mla_q_norm_g, mla_w_qb, mla_kv_norm_g, mla_w_kvb, w_out, norm_mlp_g,
              w_mlp_in, w_mlp_out, final_norm_g):
    split_points = np.cumsum(IN_SIZES)[:-1].tolist()
    h = x
    c_act = jax.nn.silu(c)
    for l in range(DEPTH):
        mod = c_act @ w_mod[l] + b_mod[l]
        sh_m, sc_m, gt_m, sh_f, sc_f, gt_f = (m[:, None, :] for m in jnp.split(mod, N_MOD, axis=-1))
        u = rmsnorm(h, norm_mix_g[l]) * (1.0 + sc_m) + sh_m
        proj = u @ w_in[l]
        gq, gk, gv, gz, ga, gb, rx, rgate, mq, mkv, mkr = jnp.split(proj, split_points, axis=-1)
        o_a = gdn_mixer(gq, gk, gv, gz, ga, gb, gdn_conv_w[l], gdn_a_log[l], gdn_dt_bias[l], gdn_norm_g[l])
        o_b = rglru_mixer(rx, rgate, rg_conv_w[l], rg_conv_b[l], rg_w_a[l], rg_b_a[l],
                          rg_w_x[l], rg_b_x[l], rg_lambda[l])
        o_c = mla_mixer(mq, mkv, mkr, positions, mla_q_norm_g[l], mla_w_qb[l],
                        mla_kv_norm_g[l], mla_w_kvb[l])
        mix = jnp.concatenate([o_a, o_b, o_c], axis=-1) @ w_out[l]
        h = h + gt_m * mix
        u = rmsnorm(h, norm_mlp_g[l]) * (1.0 + sc_f) + sh_f
        f = jnp.square(jax.nn.relu(u @ w_mlp_in[l])) @ w_mlp_out[l]
        h = h + gt_f * f
    return rmsnorm(h, final_norm_g)
```

```cpp
#include <hip/hip_runtime.h>
#include <hip/hip_cooperative_groups.h>
#include <cstdio>
#include <cstdint>
namespace cg = cooperative_groups;

#ifndef MK_N_LAUNCHES
#define MK_N_LAUNCHES 1
#endif

#define LAS __attribute__((address_space(3)))
typedef unsigned short bf16_t;
typedef short bf16x8 __attribute__((ext_vector_type(8)));
typedef short s16x4 __attribute__((ext_vector_type(4)));
typedef float f32x4 __attribute__((ext_vector_type(4)));
typedef float f32x2 __attribute__((ext_vector_type(2)));
typedef unsigned u32x4 __attribute__((ext_vector_type(4)));
typedef unsigned u32x2 __attribute__((ext_vector_type(2)));

constexpr int NB = 16, NS = 2048, ND = 1024, NT = NB * NS, NDIN = 2472, NDINP = 2560, NFF = 4096;
constexpr float EPS = 1e-6f;
constexpr int NWAVES = 8, NTHREADS = 512;
constexpr int LDS_BYTES = 147456;

constexpr size_t MiB = 1u << 20;
constexpr size_t WS_CTL = 0;
constexpr size_t WS_BAR = 64 * 1024;
constexpr size_t WS_MOD = 1 * MiB;
constexpr size_t WS_COS = 2 * MiB;
constexpr size_t WS_SIN = 4 * MiB;
constexpr size_t WS_G = 6 * MiB;
constexpr size_t WS_BETA = 6 * MiB + 512 * 1024;
constexpr size_t WS_SSQ = 56 * MiB;
constexpr size_t WS_CD = 7 * MiB + 512 * 1024;
constexpr size_t WS_SMALL = 7 * MiB + 768 * 1024;
constexpr size_t WS_WIN = 8 * MiB;
constexpr size_t WS_WMLA = 18 * MiB;
constexpr size_t WS_WOUT = 20 * MiB;
constexpr size_t WS_W1 = 24 * MiB;
constexpr size_t WS_W2 = 40 * MiB;
constexpr size_t WS_U = 64 * MiB;
constexpr size_t WS_PROJ = 128 * MiB;
constexpr size_t WS_GDN = 288 * MiB;
constexpr size_t WS_VT = 368 * MiB;
constexpr size_t WS_QB = 384 * MiB;
constexpr size_t WS_KB = 408 * MiB;
constexpr size_t WS_HID = 128 * MiB;
constexpr size_t WS_HS = 432 * MiB;
constexpr size_t WS_SSQH = 57 * MiB;
constexpr size_t WS_SHW = 60 * MiB;
constexpr size_t WS_END = 496 * MiB;
constexpr size_t GDN_ARR = (size_t)2048 * 4096;

__device__ __forceinline__ float bf2f(unsigned short b) { return __uint_as_float(((unsigned)b) << 16); }
__device__ __forceinline__ float bflo(unsigned v) { return __uint_as_float(v << 16); }
__device__ __forceinline__ float bfhi(unsigned v) { return __uint_as_float(v & 0xffff0000u); }
typedef __bf16 bf16x2_t __attribute__((ext_vector_type(2)));
__device__ __forceinline__ unsigned cvt_pk_bf16(float lo, float hi) { const f32x2 v = {lo, hi}; return __builtin_bit_cast(unsigned, __builtin_convertvector(v, bf16x2_t)); }
__device__ __forceinline__ unsigned short f2bf(float f) { return (unsigned short)(cvt_pk_bf16(f, 0.f) & 0xffffu); }
__device__ __forceinline__ float sigmoidf_(float x) { return __builtin_amdgcn_rcpf(1.0f + __expf(-x)); }
__device__ __forceinline__ float siluf_(float x) { return x * sigmoidf_(x); }
__device__ __forceinline__ float softplusf_(float x) { return x > 20.f ? x : log1pf(__expf(x)); }
__device__ __forceinline__ float shx(float v, int mask, int lane) { return __builtin_bit_cast(float, __builtin_amdgcn_ds_bpermute((lane ^ mask) << 2, __builtin_bit_cast(int, v))); }
__device__ __forceinline__ float shl_(float v, int src) { return __builtin_bit_cast(float, __builtin_amdgcn_ds_bpermute(src << 2, __builtin_bit_cast(int, v))); }
__device__ __forceinline__ float wave_sum(float v, int lane) {
#pragma unroll
    for (int o = 1; o < 64; o <<= 1) v += shx(v, o, lane);
    return v;
}
__device__ __forceinline__ float dpp_xor1(float v) { return __builtin_bit_cast(float, __builtin_amdgcn_update_dpp(0, __builtin_bit_cast(int, v), 0xB1, 0xF, 0xF, true)); }
__device__ __forceinline__ float dpp_xor2(float v) { return __builtin_bit_cast(float, __builtin_amdgcn_update_dpp(0, __builtin_bit_cast(int, v), 0x4E, 0xF, 0xF, true)); }
__device__ __forceinline__ float dpp_hmirror(float v) { return __builtin_bit_cast(float, __builtin_amdgcn_update_dpp(0, __builtin_bit_cast(int, v), 0x141, 0xF, 0xF, true)); }
__device__ __forceinline__ float dpp_rmirror(float v) { return __builtin_bit_cast(float, __builtin_amdgcn_update_dpp(0, __builtin_bit_cast(int, v), 0x140, 0xF, 0xF, true)); }
__device__ __forceinline__ f32x4 mfma16(bf16x8 a, bf16x8 b, f32x4 c) { return __builtin_amdgcn_mfma_f32_16x16x32_bf16(a, b, c, 0, 0, 0); }

struct KArgs {
    const float* in[27];
    float* out;
    unsigned char* ws;
    int ph_lo, ph_hi;
};
struct Ctx { unsigned char* ws; float* out; const KArgs* ka; int bx, G, wid; };
__device__ __forceinline__ const float* inp(const Ctx& c, int k) { return c.ka->in[k]; }
__device__ __forceinline__ int opaque_lane() { int z; asm volatile("v_mov_b32 %0, 0" : "=v"(z)); return __builtin_amdgcn_mbcnt_hi(-1, __builtin_amdgcn_mbcnt_lo(-1, z)); }
__device__ __forceinline__ int opaque_tid(int wid) { return wid * 64 + opaque_lane(); }

namespace pg8 {
constexpr int BM = 256, BK = 64, HALF = 128, HTB = HALF * BK * 2, STAGE_BYTES = 8 * HTB, NXCD = 8, WGM = 8;
__host__ __device__ __forceinline__ int lds_byte(int r, int c) { const int st = (r >> 4) * 2 + (c >> 5), rr = r & 15, cc = c & 31, ob = rr * 64 + cc * 2; return st * 1024 + (ob ^ (((ob >> 9) & 1) << 5)); }
__host__ __device__ __forceinline__ void stage_rc(int b, int& R, int& C) { const int st = b / 1024, sb = b % 1024, swz = sb ^ (((sb >> 9) & 1) << 5); R = (st >> 1) * 16 + swz / 64; C = (st & 1) * 32 + (swz % 64) / 2; }
__host__ __device__ __forceinline__ int perm32(int rho) { const int n = rho >> 4, i = rho & 15; return 8 * (i >> 2) + 4 * n + (i & 3); }

struct Unit { int pm, pn; };
struct Gemm { const bf16_t* A; const bf16_t* Bt; int M, N, K, lda, ldb; };

struct StaticOrder {
    int nM, nN, nwg, G, c;
    __device__ void init(int M, int N, int G_, int c_) { nM = M / BM; nN = N / BM; nwg = nM * nN; G = G_; c = c_; }
    __device__ bool next(int i, Unit& u) const {
        const long L = (long)i * G + c; if (L >= nwg) return false;
        int wgid = (int)L; { const int q = nwg / NXCD, r = nwg % NXCD, xcd = wgid % NXCD, off = wgid / NXCD; wgid = (xcd < r ? xcd * (q + 1) : r * (q + 1) + (xcd - r) * q) + off; }
        const int nig = WGM * nN, gid = wgid / nig, fm = gid * WGM, gsz = (nM - fm) < WGM ? (nM - fm) : WGM;
        u.pm = fm + ((wgid % nig) % gsz); u.pn = (wgid % nig) / gsz; return true;
    }
};

template <class Epi>
__device__ __forceinline__ void gemm_phase(LAS unsigned char* lds, const Gemm g, const StaticOrder& S, const Epi& E, const int wid) {
    const int lane = opaque_lane(), tid = wid * 64 + lane, wr = wid >> 2, wc = wid & 3, fr = lane & 15, fq = lane >> 4;
    const int K = g.K, nt = K / BK;
    unsigned voffA[2], voffB[2];
#pragma unroll
    for (int i = 0; i < 2; ++i) { int R, C; stage_rc(tid * 16 + i * 8192, R, C); const int Rb = Epi::PERM ? ((R & ~31) + perm32(R & 31)) : R;
        voffA[i] = (unsigned)(R * g.lda + C) * 2u; voffB[i] = (unsigned)(Rb * g.ldb + C) * 2u; }
    const __amdgpu_buffer_rsrc_t rA = __builtin_amdgcn_make_buffer_rsrc((void*)g.A, 0, -1, 0x00020000);
    const __amdgpu_buffer_rsrc_t rB = __builtin_amdgcn_make_buffer_rsrc((void*)g.Bt, 0, -1, 0x00020000);
    const unsigned kstep = (unsigned)(BK * 2);
    const unsigned hsA = (unsigned)HALF * g.lda * 2u, hsB = (unsigned)HALF * g.ldb * 2u;
    const unsigned tsA = 2u * hsA, tsB = 2u * hsB;
    const unsigned ldsw = (unsigned)wid * 1024u;
    const int aoff = lds_byte(wr * 64 + fr, fq * 8), boff = lds_byte(wc * 32 + fr, fq * 8);
#define PG8_SA(b, h) (((b) * 2 + (h)) * HTB)
#define PG8_SB(b, h) ((4 + (b) * 2 + (h)) * HTB)
#define PG8_STAGE(bufoff, rsrc, soff, voff) do { _Pragma("unroll") for (int _i = 0; _i < 2; ++_i) \
        __builtin_amdgcn_raw_ptr_buffer_load_lds(rsrc, (LAS void*)(lds + (bufoff) + ldsw + _i * 8192), 16, (int)(voff)[_i], (int)(soff), 0, 0); } while (0)
#define PG8_LDA(dst, b, h) do { _Pragma("unroll") for (int m = 0; m < 4; ++m) _Pragma("unroll") for (int k = 0; k < 2; ++k) dst[m][k] = *(const LAS bf16x8*)(lds + PG8_SA(b, h) + aoff + m * 2048 + k * 1024); } while (0)
#define PG8_LDB(dst, b, h) do { _Pragma("unroll") for (int n = 0; n < 2; ++n) _Pragma("unroll") for (int k = 0; k < 2; ++k) dst[n][k] = *(const LAS bf16x8*)(lds + PG8_SB(b, h) + boff + n * 2048 + k * 1024); } while (0)
#define PG8_MMA(ai, bj, At, Bt) do { __builtin_amdgcn_s_setprio(1); _Pragma("unroll") for (int m = 0; m < 4; ++m) _Pragma("unroll") for (int n = 0; n < 2; ++n) _Pragma("unroll") for (int k = 0; k < 2; ++k) \
        acc[ai][bj][m][n] = __builtin_amdgcn_mfma_f32_16x16x32_bf16(Bt[n][k], At[m][k], acc[ai][bj][m][n], 0, 0, 0); __builtin_amdgcn_s_setprio(0); } while (0)
#define PG8_WAIT_V(n) asm volatile("s_waitcnt vmcnt(" #n ")" ::: "memory")
#define PG8_WAIT_L(n) asm volatile("s_waitcnt lgkmcnt(" #n ")" ::: "memory")
#define PG8_BAR __builtin_amdgcn_s_barrier()
#define PG8_SCHED __builtin_amdgcn_sched_barrier(0)
    Unit cur, nxt; int ui = 0;
    if (!S.next(0, cur)) return;
    f32x4 acc[2][2][4][2];
#pragma unroll
    for (int a = 0; a < 2; ++a)
#pragma unroll
        for (int b = 0; b < 2; ++b)
#pragma unroll
            for (int m = 0; m < 4; ++m)
#pragma unroll
                for (int n = 0; n < 2; ++n) acc[a][b][m][n] = (f32x4){0.f, 0.f, 0.f, 0.f};
    bf16x8 At[4][2], B0[2][2], B1[2][2];
    unsigned cA = (unsigned)cur.pm * tsA, cB = (unsigned)cur.pn * tsB;
    PG8_STAGE(PG8_SB(0, 0), rB, cB, voffB); PG8_STAGE(PG8_SB(0, 1), rB, cB + hsB, voffB); PG8_STAGE(PG8_SA(0, 0), rA, cA, voffA); PG8_STAGE(PG8_SA(0, 1), rA, cA + hsA, voffA);
    if (wr == 1) PG8_BAR;
    PG8_WAIT_V(2); PG8_BAR;
    PG8_STAGE(PG8_SB(1, 0), rB, cB + kstep, voffB); PG8_STAGE(PG8_SA(1, 0), rA, cA + kstep, voffA); PG8_STAGE(PG8_SB(1, 1), rB, cB + hsB + kstep, voffB);
    PG8_WAIT_V(6); PG8_BAR;
    for (;;) {
        const bool has_next = S.next(ui + 1, nxt);
        const unsigned nA = has_next ? (unsigned)nxt.pm * tsA : cA, nB = has_next ? (unsigned)nxt.pn * tsB : cB;
        for (int t = 0; t < nt; t += 2) {
            const bool last = (t == nt - 2);
            const unsigned a1 = cA + (unsigned)(t + 1) * kstep;
            const unsigned a2 = last ? nA : cA + (unsigned)(t + 2) * kstep, b2 = last ? nB : cB + (unsigned)(t + 2) * kstep;
            const unsigned a3 = a2 + kstep, b3 = b2 + kstep;
            PG8_LDB(B0, 0, 0); PG8_LDB(B1, 0, 1); PG8_SCHED; PG8_LDA(At, 0, 0); PG8_STAGE(PG8_SA(1, 1), rA, a1 + hsA, voffA);
            PG8_WAIT_V(8); PG8_WAIT_L(0); PG8_BAR; PG8_MMA(0, 0, At, B0); PG8_MMA(0, 1, At, B1); PG8_BAR; PG8_SCHED;
            PG8_LDA(At, 0, 1); PG8_STAGE(PG8_SB(0, 0), rB, b2, voffB); PG8_STAGE(PG8_SB(0, 1), rB, b2 + hsB, voffB); PG8_STAGE(PG8_SA(0, 0), rA, a2, voffA);
            PG8_WAIT_V(8); PG8_WAIT_L(0); PG8_BAR; PG8_MMA(1, 0, At, B0); PG8_MMA(1, 1, At, B1); PG8_BAR; PG8_SCHED;
            PG8_LDB(B0, 1, 0); PG8_LDB(B1, 1, 1); PG8_SCHED; PG8_LDA(At, 1, 0); PG8_STAGE(PG8_SA(0, 1), rA, a2 + hsA, voffA);
            PG8_WAIT_V(8); PG8_WAIT_L(0); PG8_BAR; PG8_MMA(0, 0, At, B0); PG8_MMA(0, 1, At, B1); PG8_BAR; PG8_SCHED;
            PG8_LDA(At, 1, 1); PG8_STAGE(PG8_SB(1, 0), rB, b3, voffB); PG8_STAGE(PG8_SB(1, 1), rB, b3 + hsB, voffB); PG8_STAGE(PG8_SA(1, 0), rA, a3, voffA);
            PG8_WAIT_V(8); PG8_WAIT_L(0); PG8_BAR; PG8_MMA(1, 0, At, B0); PG8_MMA(1, 1, At, B1); PG8_BAR; PG8_SCHED;
        }
        if (wr == 0) PG8_BAR;
        E(acc, cur, wr, wc, fr, fq);
        if (!has_next) break;
#pragma unroll
        for (int a = 0; a < 2; ++a)
#pragma unroll
            for (int b = 0; b < 2; ++b)
#pragma unroll
                for (int m = 0; m < 4; ++m)
#pragma unroll
                    for (int n = 0; n < 2; ++n) acc[a][b][m][n] = (f32x4){0.f, 0.f, 0.f, 0.f};
        cur = nxt; cA = nA; cB = nB; ++ui;
        if (wr == 1) PG8_BAR;
    }
    PG8_WAIT_V(0);
    PG8_BAR;
#undef PG8_SA
#undef PG8_SB
#undef PG8_STAGE
#undef PG8_LDA
#undef PG8_LDB
#undef PG8_MMA
#undef PG8_WAIT_V
#undef PG8_WAIT_L
#undef PG8_BAR
#undef PG8_SCHED
}

template <bool FUSE>
struct EpiInProj {
    static constexpr bool PERM = true;
    unsigned char* ws; int l;
    __device__ __forceinline__ void operator()(const f32x4 (&acc)[2][2][4][2], const Unit& u, int wr, int wc, int fr, int fq) const {
        asm volatile("" : "+v"(fr), "+v"(fq));
        bf16_t* proj = (bf16_t*)(ws + WS_PROJ); float* ssq = (float*)(ws + WS_SSQ); float* G = (float*)(ws + WS_G); float* BETA = (float*)(ws + WS_BETA); bf16_t* KB = (bf16_t*)(ws + WS_KB);
        const float* cosT = (const float*)(ws + WS_COS); const float* sinT = (const float*)(ws + WS_SIN); const float* a_log = (const float*)(ws + WS_SMALL) + l * 4; const float* dt_bias = a_log + 8;
        const int row0 = u.pm * BM + wr * 64 + fr, colb = u.pn * BM + wc * 32 + 8 * fq;
        float rs[2][4]; f32x4 sw[2][2];
        if (FUSE) { f32x4 pp[2][4]; const float* ssqh = (const float*)(ws + WS_SSQH);
#pragma unroll
            for (int ai = 0; ai < 2; ++ai)
#pragma unroll
                for (int m = 0; m < 4; ++m) pp[ai][m] = *(const f32x4*)(ssqh + (size_t)(row0 + ai * HALF + m * 16) * 16 + 4 * fq);
            const float* shw = (const float*)(ws + WS_SHW) + (size_t)(16 + ((u.pm * BM) >> 11)) * 4096 + colb;
#pragma unroll
            for (int bj = 0; bj < 2; ++bj) { sw[bj][0] = *(const f32x4*)(shw + bj * HALF); sw[bj][1] = *(const f32x4*)(shw + bj * HALF + 4); }
#pragma unroll
            for (int ai = 0; ai < 2; ++ai)
#pragma unroll
                for (int m = 0; m < 4; ++m) { float sacc = (pp[ai][m][0] + pp[ai][m][1]) + (pp[ai][m][2] + pp[ai][m][3]); sacc += shx(sacc, 16, fr + 16 * fq); sacc += shx(sacc, 32, fr + 16 * fq);
                    rs[ai][m] = rsqrtf(sacc * (1.0f / ND) + EPS); } }
#pragma unroll
        for (int ai = 0; ai < 2; ++ai)
#pragma unroll
            for (int m = 0; m < 4; ++m) {
                const int r = row0 + ai * HALF + m * 16;
                bf16_t* rowp = proj + (size_t)r * NDINP + colb;
                f32x4 t[2][2];
#pragma unroll
                for (int bj = 0; bj < 2; ++bj) { t[bj][0] = acc[ai][bj][m][0]; t[bj][1] = acc[ai][bj][m][1]; }
                if (FUSE) {
                    const float rstd = rs[ai][m];
#pragma unroll
                    for (int bj = 0; bj < 2; ++bj) { t[bj][0] = t[bj][0] * rstd + sw[bj][0]; t[bj][1] = t[bj][1] * rstd + sw[bj][1]; } }
#pragma unroll
                for (int bj = 0; bj < 2; ++bj) { const f32x4 v0 = t[bj][0], v1 = t[bj][1];
                    u32x4 w; w.x = cvt_pk_bf16(v0[0], v0[1]); w.y = cvt_pk_bf16(v0[2], v0[3]); w.z = cvt_pk_bf16(v1[0], v1[1]); w.w = cvt_pk_bf16(v1[2], v1[3]);
                    *(u32x4*)(rowp + bj * HALF) = w; }
                if (u.pn == 8) {
                    float s = 0.f;
#pragma unroll
                    for (int bj = 0; bj < 2; ++bj)
#pragma unroll
                        for (int n = 0; n < 2; ++n) { const f32x4 x = t[bj][n]; s += (x[0] * x[0] + x[1] * x[1]) + (x[2] * x[2] + x[3] * x[3]); }
                    s += shx(s, 16, fr + 16 * fq); s += shx(s, 32, fr + 16 * fq);
                    if (fq == 0) ssq[8 * r + wc] = s;
                }
                if (u.pn == 9) {
                    float s = 0.f;
#pragma unroll
                    for (int n = 0; n < 2; ++n) { const f32x4 x = t[0][n]; s += (x[0] * x[0] + x[1] * x[1]) + (x[2] * x[2] + x[3] * x[3]); }
                    s += shx(s, 16, fr + 16 * fq); s += shx(s, 32, fr + 16 * fq);
                    if (fq == 0) ssq[8 * r + 4 + wc] = s;
                    if (wc == 0) {
                        const f32x4 x1 = t[1][0], x2 = t[1][1];
                        const f32x4 c = *(const f32x4*)(cosT + (size_t)r * 16 + 4 * fq), sn = *(const f32x4*)(sinT + (size_t)r * 16 + 4 * fq);
                        const f32x4 o1 = x1 * c - x2 * sn, o2 = x2 * c + x1 * sn;
                        u32x4 w; w.x = cvt_pk_bf16(o1[0], o1[1]); w.y = cvt_pk_bf16(o1[2], o1[3]); w.z = cvt_pk_bf16(o2[0], o2[1]); w.w = cvt_pk_bf16(o2[2], o2[3]);
                        const int b = r >> 11, sq = r & 2047;
#pragma unroll
                        for (int h = 0; h < 4; ++h) *(u32x4*)(KB + ((size_t)(b * 4 + h) * NS + sq) * 96 + 64 + 8 * fq) = w;
                    }
                    if (wc == 1 && fq == 0) {
                        const f32x4 av = t[1][0], bv = t[1][1];
                        f32x4 gg, bb;
#pragma unroll
                        for (int h = 0; h < 4; ++h) { gg[h] = -__expf(a_log[h]) * softplusf_(av[h] + dt_bias[h]); bb[h] = sigmoidf_(bv[h]); }
                        *(f32x4*)(G + (size_t)r * 4) = gg; *(f32x4*)(BETA + (size_t)r * 4) = bb;
                    }
                }
                asm volatile("" ::: "memory");
            }
    }
};

struct EpiMLA {
    static constexpr bool PERM = true;
    unsigned char* ws;
    __device__ __forceinline__ void operator()(const f32x4 (&acc)[2][2][4][2], const Unit& u, int wr, int wc, int fr, int fq) const {
        asm volatile("" : "+v"(fr), "+v"(fq));
        bf16_t* QB = (bf16_t*)(ws + WS_QB); bf16_t* KB = (bf16_t*)(ws + WS_KB); bf16_t* VT = (bf16_t*)(ws + WS_VT); const float* ssq = (const float*)(ws + WS_SSQ);
        const float* cosT = (const float*)(ws + WS_COS); const float* sinT = (const float*)(ws + WS_SIN);
        const int row0 = u.pm * BM + wr * 64 + fr;
        const float QSCALE = 0.10206207261596577f * 1.4426950408889634f;
        f32x2 pp[2][4]; float rq8[2][4], rkv8[2][4];
#pragma unroll
        for (int ai = 0; ai < 2; ++ai)
#pragma unroll
            for (int m = 0; m < 4; ++m) pp[ai][m] = *(const f32x2*)(ssq + 8 * (size_t)(row0 + ai * HALF + m * 16) + 2 * fq);
#pragma unroll
        for (int ai = 0; ai < 2; ++ai)
#pragma unroll
            for (int m = 0; m < 4; ++m) { float mine = pp[ai][m].x + pp[ai][m].y; mine += shx(mine, 16, fr + 16 * fq); const float other = shx(mine, 32, fr + 16 * fq);
                const float sq_ = (fq < 2) ? mine : other, sk_ = (fq < 2) ? other : mine;
                rq8[ai][m] = rsqrtf(sq_ * (1.0f / 256.0f) + EPS); rkv8[ai][m] = rsqrtf(sk_ * (1.0f / 128.0f) + EPS); }
#pragma unroll
        for (int ai = 0; ai < 2; ++ai)
#pragma unroll
            for (int m = 0; m < 4; ++m) {
                const int r = row0 + ai * HALF + m * 16;
                const int b = r >> 11, sq = r & 2047;
                const float rq = rq8[ai][m], rkv = rkv8[ai][m];
                if (u.pn != 1) {
                    const float sc = (u.pn == 0) ? rq * QSCALE : rkv;
                    bf16_t* base = (u.pn == 0) ? QB : ((u.pn == 2) ? KB : VT);
                    const int rl = (u.pn == 3) ? 64 : 96;
#pragma unroll
                    for (int bj = 0; bj < 2; ++bj) { const int cq = 128 * bj + 32 * wc + 8 * fq, head = cq >> 6, d = cq & 63;
                        const f32x4 v0 = acc[ai][bj][m][0] * sc, v1 = acc[ai][bj][m][1] * sc;
                        u32x4 w; w.x = cvt_pk_bf16(v0[0], v0[1]); w.y = cvt_pk_bf16(v0[2], v0[3]); w.z = cvt_pk_bf16(v1[0], v1[1]); w.w = cvt_pk_bf16(v1[2], v1[3]);
                        *(u32x4*)(base + ((size_t)(b * 4 + head) * NS + sq) * rl + d) = w; }
                } else {
                    const f32x4 x1 = acc[ai][0][m][0] * rq, x2 = acc[ai][0][m][1] * rq;
                    const f32x4 c = *(const f32x4*)(cosT + (size_t)r * 16 + 4 * fq), sn = *(const f32x4*)(sinT + (size_t)r * 16 + 4 * fq);
                    const f32x4 o1 = (x1 * c - x2 * sn) * QSCALE, o2 = (x2 * c + x1 * sn) * QSCALE;
                    u32x4 w; w.x = cvt_pk_bf16(o1[0], o1[1]); w.y = cvt_pk_bf16(o1[2], o1[3]); w.z = cvt_pk_bf16(o2[0], o2[1]); w.w = cvt_pk_bf16(o2[2], o2[3]);
                    *(u32x4*)(QB + ((size_t)(b * 4 + wc) * NS + sq) * 96 + 64 + 8 * fq) = w;
                }
                asm volatile("" ::: "memory");
            }
    }
};

template <bool FUSE>
struct EpiResid {
    static constexpr bool PERM = false;
    const float* base; float* out; const float* gate; const float* gain; const float* scp; bf16_t* hs; float* ssqh;
    __device__ __forceinline__ void operator()(const f32x4 (&acc)[2][2][4][2], const Unit& u, int wr, int wc, int fr, int fq) const {
        asm volatile("" : "+v"(fr), "+v"(fq));
        const int row0 = u.pm * BM + wr * 64 + fr, col0 = u.pn * BM + wc * 32 + 4 * fq;
        const int b = (u.pm * BM) >> 11;
        f32x4 gv[2][2], gs[2][2];
#pragma unroll
        for (int bj = 0; bj < 2; ++bj)
#pragma unroll
            for (int n = 0; n < 2; ++n) { gv[bj][n] = *(const f32x4*)(gate + (size_t)b * 6144 + col0 + bj * HALF + n * 16);
                if (FUSE) gs[bj][n] = *(const f32x4*)(gain + col0 + bj * HALF + n * 16) * (*(const f32x4*)(scp + (size_t)b * 6144 + col0 + bj * HALF + n * 16) + 1.0f); }
        f32x4 cur[2][2], nxt[2][2];
#pragma unroll
        for (int bj = 0; bj < 2; ++bj)
#pragma unroll
            for (int n = 0; n < 2; ++n) cur[bj][n] = *(const f32x4*)(base + (size_t)row0 * ND + col0 + bj * HALF + n * 16);
#pragma unroll
        for (int it = 0; it < 8; ++it) { const int ai = it >> 2, m = it & 3;
            const int r = row0 + ai * HALF + m * 16; const size_t off = (size_t)r * ND + col0; float ssum = 0.f;
            if (it < 7) { const size_t offn = (size_t)(row0 + ((it + 1) >> 2) * HALF + ((it + 1) & 3) * 16) * ND + col0;
#pragma unroll
                for (int bj = 0; bj < 2; ++bj)
#pragma unroll
                    for (int n = 0; n < 2; ++n) nxt[bj][n] = *(const f32x4*)(base + offn + bj * HALF + n * 16); }
#pragma unroll
            for (int bj = 0; bj < 2; ++bj)
#pragma unroll
                for (int n = 0; n < 2; ++n) {
                    const f32x4 o = cur[bj][n] + gv[bj][n] * acc[ai][bj][m][n];
                    __builtin_nontemporal_store(o, (f32x4*)(out + off + bj * HALF + n * 16));
                    if (FUSE) { ssum += (o[0] * o[0] + o[1] * o[1]) + (o[2] * o[2] + o[3] * o[3]); const f32x4 hv = o * gs[bj][n];
                        u32x2 w; w.x = cvt_pk_bf16(hv[0], hv[1]); w.y = cvt_pk_bf16(hv[2], hv[3]); *(u32x2*)(hs + off + bj * HALF + n * 16) = w; } }
            if (FUSE) { ssum += shx(ssum, 16, fr + 16 * fq); ssum += shx(ssum, 32, fr + 16 * fq); if (fq == 0) ssqh[(size_t)r * 16 + u.pn * 4 + wc] = ssum; }
            asm volatile("" ::: "memory");
#pragma unroll
            for (int bj = 0; bj < 2; ++bj)
#pragma unroll
                for (int n = 0; n < 2; ++n) cur[bj][n] = nxt[bj][n]; }
    }
};

template <bool FUSE>
struct EpiRelu2 {
    static constexpr bool PERM = true;
    bf16_t* O; int ldc; const float* ssqh; const float* shw;
    __device__ __forceinline__ void operator()(const f32x4 (&acc)[2][2][4][2], const Unit& u, int wr, int wc, int fr, int fq) const {
        asm volatile("" : "+v"(fr), "+v"(fq));
        const int row0 = u.pm * BM + wr * 64 + fr, col0 = u.pn * BM + wc * 32 + 8 * fq;
        const int b = (u.pm * BM) >> 11;
        f32x4 sw[2][2];
        if (FUSE) {
#pragma unroll
            for (int bj = 0; bj < 2; ++bj) { sw[bj][0] = *(const f32x4*)(shw + (size_t)b * 4096 + col0 + bj * HALF); sw[bj][1] = *(const f32x4*)(shw + (size_t)b * 4096 + col0 + bj * HALF + 4); } }
        float rs[2][4];
        if (FUSE) { f32x4 pp[2][4];
#pragma unroll
            for (int ai = 0; ai < 2; ++ai)
#pragma unroll
                for (int m = 0; m < 4; ++m) pp[ai][m] = *(const f32x4*)(ssqh + (size_t)(row0 + ai * HALF + m * 16) * 16 + 4 * fq);
#pragma unroll
            for (int ai = 0; ai < 2; ++ai)
#pragma unroll
                for (int m = 0; m < 4; ++m) { float sacc = (pp[ai][m][0] + pp[ai][m][1]) + (pp[ai][m][2] + pp[ai][m][3]); sacc += shx(sacc, 16, fr + 16 * fq); sacc += shx(sacc, 32, fr + 16 * fq);
                    rs[ai][m] = rsqrtf(sacc * (1.0f / ND) + EPS); } }
#pragma unroll
        for (int ai = 0; ai < 2; ++ai)
#pragma unroll
            for (int m = 0; m < 4; ++m) { const int r = row0 + ai * HALF + m * 16; bf16_t* rowp = O + (size_t)r * ldc + col0;
                const float rstd = FUSE ? rs[ai][m] : 1.0f;
#pragma unroll
                for (int bj = 0; bj < 2; ++bj) { f32x4 v0 = acc[ai][bj][m][0], v1 = acc[ai][bj][m][1];
                    if (FUSE) { v0 = v0 * rstd + sw[bj][0]; v1 = v1 * rstd + sw[bj][1]; }
#pragma unroll
                    for (int j = 0; j < 4; ++j) { const float a = fmaxf(v0[j], 0.f), c = fmaxf(v1[j], 0.f); v0[j] = a * a; v1[j] = c * c; }
                    u32x4 w; w.x = cvt_pk_bf16(v0[0], v0[1]); w.y = cvt_pk_bf16(v0[2], v0[3]); w.z = cvt_pk_bf16(v1[0], v1[1]); w.w = cvt_pk_bf16(v1[2], v1[3]);
                    __builtin_nontemporal_store(w, (u32x4*)(rowp + bj * HALF)); } }
    }
};
}

__device__ __forceinline__ float wval(const Ctx& a, int mat, int l, int k, int n) {
    if (mat == 0) {
        int src;
        if (n < 1024) src = n;
        else if (n < 2432) src = n + 8;
        else if (n < 2464) { const int p = n - 2432, g = p >> 3, w = p & 7; src = 2440 + ((w < 4) ? 4 * g + w : 16 + 4 * g + (w - 4)); }
        else if (n < 2472) src = 1024 + (n - 2464);
        else return 0.f;
        return inp(a, 6)[((size_t)l * 1024 + k) * NDIN + src];
    } else if (mat == 1) {
        if (n < 384) {
            if (k >= 256) return 0.f;
            int col;
            if (n < 256) col = (n >> 6) * 96 + (n & 63);
            else { const int p = n - 256, head = p >> 5, pp = p & 31, g = pp >> 3, w = pp & 7; col = head * 96 + 64 + ((w < 4) ? 4 * g + w : 16 + 4 * g + (w - 4)); }
            return inp(a, 19)[((size_t)l * 256 + k) * 384 + col] * inp(a, 18)[l * 256 + k];
        } else if (n < 512) return 0.f;
        else {
            if (k < 256) return 0.f;
            const int kk = k - 256, mm = (n - 512) & 255, head = mm >> 6, d = mm & 63;
            const int col = head * 128 + ((n >= 768) ? 64 : 0) + d;
            return inp(a, 21)[((size_t)l * 128 + kk) * 512 + col] * inp(a, 20)[l * 128 + kk];
        }
    } else if (mat == 2) return inp(a, 22)[((size_t)l * 1024 + k) * 1024 + n];
    else if (mat == 3) return inp(a, 24)[((size_t)l * 1024 + k) * 4096 + n];
    else return inp(a, 25)[((size_t)l * 4096 + k) * 1024 + n];
}

__device__ __forceinline__ void transpose_item(const Ctx& a, int mat, int l, int K, int N, bf16_t* WT, LAS float* scr, int item, int lane) {
    const int nblk = N / 32, kb = item / nblk, nb = item % nblk, k0 = 64 * kb, n0 = 32 * nb;
    float wv[32];
#pragma unroll
    for (int i = 0; i < 32; ++i) wv[i] = wval(a, mat, l, k0 + 2 * i + (lane >> 5), n0 + (lane & 31));
#pragma unroll
    for (int i = 0; i < 32; ++i) scr[(2 * i + (lane >> 5)) * 33 + (lane & 31)] = wv[i];
    asm volatile("s_waitcnt lgkmcnt(0)" ::: "memory");
    const int c = lane & 7;
#pragma unroll
    for (int j = 0; j < 4; ++j) { const int n = (lane >> 3) + 8 * j; const LAS float* s = scr + (8 * c) * 33 + n;
        u32x4 o; o.x = cvt_pk_bf16(s[0 * 33], s[1 * 33]); o.y = cvt_pk_bf16(s[2 * 33], s[3 * 33]); o.z = cvt_pk_bf16(s[4 * 33], s[5 * 33]); o.w = cvt_pk_bf16(s[6 * 33], s[7 * 33]);
        *(u32x4*)(WT + (size_t)(n0 + n) * K + k0 + 8 * c) = o; }
    asm volatile("s_waitcnt lgkmcnt(0)" ::: "memory");
}

__device__ __forceinline__ void prologue_phase(const Ctx& a, LAS unsigned char* lds) {
    const int tid = opaque_tid(a.wid), lane = tid & 63, wave = tid >> 6;
    const int G = a.G, bx = a.bx, gw = bx * NWAVES + wave, NGW = G * NWAVES;
    unsigned char* ws = a.ws;
    if (bx == 0) { unsigned* ctl = (unsigned*)(ws + WS_CTL); for (int i = tid; i < 1024; i += NTHREADS) ctl[i] = 0u;
        if (tid < 8) { float* sm = (float*)(ws + WS_SMALL); sm[tid] = inp(a, 8)[tid]; sm[8 + tid] = inp(a, 9)[tid]; } }
    {
        LAS float* scr = (LAS float*)(lds + wave * 8704);
        constexpr int I0 = 16 * 80, I1 = 6 * 32, I2 = 16 * 32, I3 = 16 * 128, I4 = 64 * 32, IL = I0 + I1 + I2 + I3 + I4;
        for (int it = gw; it < 2 * IL; it += NGW) {
            const int l = it / IL; int r = it % IL;
            if (r < I0) { transpose_item(a, 0, l, 1024, NDINP, (bf16_t*)(ws + WS_WIN) + (size_t)l * NDINP * 1024, scr, r, lane); continue; } r -= I0;
            if (r < I1) { transpose_item(a, 1, l, 384, 1024, (bf16_t*)(ws + WS_WMLA) + (size_t)l * 1024 * 384, scr, r, lane); continue; } r -= I1;
            if (r < I2) { transpose_item(a, 2, l, 1024, 1024, (bf16_t*)(ws + WS_WOUT) + (size_t)l * 1024 * 1024, scr, r, lane); continue; } r -= I2;
            if (r < I3) { transpose_item(a, 3, l, 1024, 4096, (bf16_t*)(ws + WS_W1) + (size_t)l * 4096 * 1024, scr, r, lane); continue; } r -= I3;
            transpose_item(a, 4, l, 4096, 1024, (bf16_t*)(ws + WS_W2) + (size_t)l * 1024 * 4096, scr, r, lane);
        }
    }
    {
        float* cosT = (float*)(ws + WS_COS); float* sinT = (float*)(ws + WS_SIN);
        const int* pos = (const int*)inp(a, 2);
        for (int idx = bx * NTHREADS + tid; idx < NT * 16; idx += G * NTHREADS) {
            const int tok = idx >> 4, i = idx & 15;
            const float inv = powf(10000.0f, -(float)(2 * i) / 32.0f);
            const float ang = (float)pos[tok] * inv;
            float s, c; sincosf(ang, &s, &c);
            cosT[idx] = c; sinT[idx] = s;
        }
    }
    __syncthreads();
    if (bx < 192) {
        LAS float* cact = (LAS float*)lds;
        LAS float* red = (LAS float*)(lds + 65536);
        for (int i = tid; i < 16 * 1024; i += NTHREADS) cact[i] = siluf_(inp(a, 1)[i]);
        __syncthreads();
        const int l = bx / 96, n0 = (bx % 96) * 64, col = tid & 63, kg = tid >> 6;
        float acc[16];
#pragma unroll
        for (int b = 0; b < 16; ++b) acc[b] = 0.f;
        const float* wp = inp(a, 3) + ((size_t)l * 1024 + kg * 128) * 6144 + n0 + col;
        for (int k4 = 0; k4 < 128; k4 += 4) {
            const float w0 = wp[(size_t)(k4 + 0) * 6144], w1 = wp[(size_t)(k4 + 1) * 6144], w2 = wp[(size_t)(k4 + 2) * 6144], w3 = wp[(size_t)(k4 + 3) * 6144];
#pragma unroll
            for (int b = 0; b < 16; ++b) { const f32x4 cv = *(const LAS f32x4*)(cact + b * 1024 + kg * 128 + k4); acc[b] += cv[0] * w0 + cv[1] * w1 + cv[2] * w2 + cv[3] * w3; }
        }
#pragma unroll
        for (int b = 0; b < 16; ++b) red[(kg * 16 + b) * 64 + col] = acc[b];
        __syncthreads();
        float* MOD = (float*)(ws + WS_MOD);
        for (int o = tid; o < 1024; o += NTHREADS) { const int b = o >> 6, cc = o & 63; float s = inp(a, 4)[l * 6144 + n0 + cc];
#pragma unroll
            for (int g2 = 0; g2 < 8; ++g2) s += red[(g2 * 16 + b) * 64 + cc];
            MOD[((size_t)l * 16 + b) * 6144 + n0 + cc] = s; }
    }
    __syncthreads();
}

__device__ __forceinline__ void norm_phase(const Ctx& a, const float* src, const float* gain, const float* modl, int sh_off, int sc_off, bool zero_ssq) {
    const int tid = opaque_tid(a.wid), lane = tid & 63, wave = tid >> 6;
    const int gw = a.bx * NWAVES + wave, NGW = a.G * NWAVES;
    bf16_t* U = (bf16_t*)(a.ws + WS_U);
    for (int row = gw; row < NT; row += NGW) {
        const int b = row >> 11;
        const f32x4* xr = (const f32x4*)(src + (size_t)row * ND) + lane;
        f32x4 v[4]; float s = 0.f;
#pragma unroll
        for (int j = 0; j < 4; ++j) { v[j] = xr[64 * j]; s += (v[j][0] * v[j][0] + v[j][1] * v[j][1]) + (v[j][2] * v[j][2] + v[j][3] * v[j][3]); }
        const float rstd = rsqrtf(wave_sum(s, lane) * (1.0f / ND) + EPS);
        u32x2* o8 = (u32x2*)(U + (size_t)row * ND) + lane;
#pragma unroll
        for (int j = 0; j < 4; ++j) { const int c = 4 * lane + 256 * j;
            const f32x4 g = *(const f32x4*)(gain + c), sc = *(const f32x4*)(modl + (size_t)b * 6144 + sc_off + c), sh = *(const f32x4*)(modl + (size_t)b * 6144 + sh_off + c);
            const f32x4 y = v[j] * rstd * g * (sc + 1.0f) + sh;
            u32x2 w; w.x = cvt_pk_bf16(y[0], y[1]); w.y = cvt_pk_bf16(y[2], y[3]); o8[64 * j] = w; }
    }
}

__device__ __forceinline__ void shw_item(const Ctx& a, LAS unsigned char* lds, const int item) {
    const int tid = opaque_tid(a.wid), lane = tid & 63, w = tid >> 6, fr = lane & 15, fq = lane >> 4;
    const int idx = (item < 32) ? 0 : ((item < 52) ? 1 : 2), n0 = ((item < 32) ? item : ((item < 52) ? item - 32 : item - 52)) * 128;
    const int l = (idx == 0) ? 0 : 1, shoff = (idx == 1) ? 0 : 3072;
    const float* MOD = (const float*)(a.ws + WS_MOD);
    const bf16_t* WT = (idx == 1) ? (const bf16_t*)(a.ws + WS_WIN) + (size_t)NDINP * 1024 : (const bf16_t*)(a.ws + WS_W1) + (size_t)l * 4096 * 1024;
    LAS bf16_t* shb = (LAS bf16_t*)lds;
    __syncthreads();
    for (int i = tid; i < 16 * 1024; i += NTHREADS) shb[(i >> 10) * 1032 + (i & 1023)] = f2bf(MOD[((size_t)l * 16 + (i >> 10)) * 6144 + shoff + (i & 1023)]);
    __syncthreads();
    const bf16_t* wrow = WT + (size_t)(n0 + 16 * w + fr) * 1024 + 8 * fq;
    f32x4 d = {0.f, 0.f, 0.f, 0.f};
#pragma unroll 8
    for (int ks = 0; ks < 32; ++ks) {
        const bf16x8 af = *(const LAS bf16x8*)(shb + fr * 1032 + 32 * ks + 8 * fq);
        const bf16x8 bf_ = *(const bf16x8*)(wrow + 32 * ks);
        d = mfma16(af, bf_, d);
    }
    float* SHW = (float*)(a.ws + WS_SHW);
#pragma unroll
    for (int r = 0; r < 4; ++r) SHW[((size_t)idx * 16 + 4 * fq + r) * 4096 + n0 + 16 * w + fr] = d[r];
}

__device__ __forceinline__ void final_norm_phase(const Ctx& a) {
    const int tid = opaque_tid(a.wid), lane = tid & 63, wave = tid >> 6;
    const int gw = a.bx * NWAVES + wave, NGW = a.G * NWAVES;
    const float* gain = inp(a, 26);
    for (int row = gw; row < NT; row += NGW) {
        f32x4* xr = (f32x4*)(a.out + (size_t)row * ND) + lane;
        f32x4 v[4]; float s = 0.f;
#pragma unroll
        for (int j = 0; j < 4; ++j) { v[j] = xr[64 * j]; s += (v[j][0] * v[j][0] + v[j][1] * v[j][1]) + (v[j][2] * v[j][2] + v[j][3] * v[j][3]); }
        const float rstd = rsqrtf(wave_sum(s, lane) * (1.0f / ND) + EPS);
#pragma unroll
        for (int j = 0; j < 4; ++j) { const f32x4 g = *(const f32x4*)(gain + 4 * lane + 256 * j); __builtin_nontemporal_store(v[j] * rstd * g, xr + 64 * j); }
    }
}

#define XB_TMO      128
#define XB_XCNT(j)  (256  + 64 * (j))
#define XB_XSUB(j)  (1280 + 64 * (j))
#define XB_XGEN(j)  (2304 + 64 * (j))
#define XB_TOP      3328
#define XB_TOPGEN   3392
#define XCD_BAR_WORDS 3456
#define XB_SPIN_CAP (1u << 22)
__device__ __forceinline__ unsigned xb_ld(unsigned* p)              { return __hip_atomic_load(p, __ATOMIC_RELAXED, __HIP_MEMORY_SCOPE_AGENT); }
__device__ __forceinline__ unsigned xb_add(unsigned* p, unsigned v) { return __hip_atomic_fetch_add(p, v, __ATOMIC_RELAXED, __HIP_MEMORY_SCOPE_AGENT); }
__device__ __forceinline__ unsigned xb_xcc_id() { return (unsigned)__builtin_amdgcn_s_getreg((3 << 11) | 20) & 0xFu; }
#define XB_SPIN(cond, bar) do { unsigned _sp = 0; while (cond) { __builtin_amdgcn_s_sleep(1); \
    if ((++_sp & 255u) == 0u) { if (xb_ld(&(bar)[XB_TMO])) break; if (_sp > XB_SPIN_CAP) { atomicAdd(&(bar)[XB_TMO], 1u); break; } } } } while (0)
__device__ __forceinline__ void xcd_barrier_complete(unsigned* bar, unsigned x, unsigned G, unsigned& nloc, unsigned& nx) {
    unsigned sum, cnt, mine, sp = 0u;
    for (;;) {
        sum = 0u; cnt = 0u; mine = 0u;
#pragma unroll
        for (unsigned j = 0; j < 16; ++j) { const unsigned c = xb_ld(&bar[XB_XCNT(j)]); sum += c; cnt += (c > 0u) ? 1u : 0u; mine = (j == x) ? c : mine; }
        if (sum == G) break;
        __builtin_amdgcn_s_sleep(1);
        if ((++sp & 255u) == 0u) { if (xb_ld(&bar[XB_TMO])) break; if (sp > XB_SPIN_CAP) { atomicAdd(&bar[XB_TMO], 1u); break; } }
    }
    nloc = mine > 0u ? mine : 1u; nx = cnt > 0u ? cnt : 1u;
}
__device__ __forceinline__ void grid_bar(unsigned* bar, int G, int wid, volatile LAS unsigned* st) {
    asm volatile("s_waitcnt vmcnt(0)" ::: "memory");
    __syncthreads();
    if (opaque_tid(wid) == 0) {
        __builtin_amdgcn_s_waitcnt(0);
        const unsigned x = xb_xcc_id();
        unsigned nloc = st[0], nx = st[1];
        if (nloc == 0u) { xcd_barrier_complete(bar, x, (unsigned)G, nloc, nx); st[0] = nloc; st[1] = nx; }
        const unsigned old = xb_add(&bar[XB_XSUB(x)], 1u);
        const unsigned gen = old / nloc;
        if (old + 1u == (gen + 1u) * nloc) {
            __builtin_amdgcn_fence(__ATOMIC_RELEASE, "agent");
            asm volatile("s_waitcnt vmcnt(0)" ::: "memory");
            const unsigned og = xb_add(&bar[XB_TOP], 1u);
            const unsigned tg = og / nx;
            if (og + 1u == (tg + 1u) * nx) xb_add(&bar[XB_TOPGEN], 1u);
            else XB_SPIN(xb_ld(&bar[XB_TOPGEN]) == tg, bar);
            __builtin_amdgcn_fence(__ATOMIC_ACQUIRE, "agent");
            xb_add(&bar[XB_XGEN(x)], 1u);
            asm volatile("s_waitcnt vmcnt(0)" ::: "memory");
        } else {
            XB_SPIN(xb_ld(&bar[XB_XGEN(x)]) == gen, bar);
            __builtin_amdgcn_fence(__ATOMIC_ACQUIRE, "agent");
            asm volatile("s_waitcnt vmcnt(0)" ::: "memory");
        }
    }
    __syncthreads();
}

__device__ __forceinline__ int q_pop(unsigned* ctr, LAS unsigned* slot, int wid) {
    __syncthreads();
    if (opaque_tid(wid) == 0) *slot = atomicAdd(ctr, 1u);
    __syncthreads();
    return (int)*slot;
}

__device__ __forceinline__ void conv8(const bf16_t* p, int rstride, int s, const float* w, int wstride, float (&o)[8]) {
#pragma unroll
    for (int e = 0; e < 8; ++e) o[e] = 0.f;
#pragma unroll
    for (int j = 0; j < 4; ++j) {
        const int d = 3 - j;
        if (s - d >= 0) {
            const u32x4 v = *(const u32x4*)(p - (size_t)d * rstride);
            const f32x4 w0 = *(const f32x4*)(w + j * wstride), w1 = *(const f32x4*)(w + j * wstride + 4);
            o[0] += w0[0] * bflo(v.x); o[1] += w0[1] * bfhi(v.x); o[2] += w0[2] * bflo(v.y); o[3] += w0[3] * bfhi(v.y);
            o[4] += w1[0] * bflo(v.z); o[5] += w1[1] * bfhi(v.z); o[6] += w1[2] * bflo(v.w); o[7] += w1[3] * bfhi(v.w);
        }
    }
}

__device__ __forceinline__ void conv8r(const u32x4 (&rows)[4], const float* w, int wstride, float (&o)[8]) {
#pragma unroll
    for (int e = 0; e < 8; ++e) o[e] = 0.f;
#pragma unroll
    for (int j = 0; j < 4; ++j) {
        const u32x4 v = rows[j];
        const f32x4 w0 = *(const f32x4*)(w + j * wstride), w1 = *(const f32x4*)(w + j * wstride + 4);
        o[0] += w0[0] * bflo(v.x); o[1] += w0[1] * bfhi(v.x); o[2] += w0[2] * bflo(v.y); o[3] += w0[3] * bfhi(v.y);
        o[4] += w1[0] * bflo(v.z); o[5] += w1[1] * bfhi(v.z); o[6] += w1[2] * bflo(v.w); o[7] += w1[3] * bfhi(v.w);
    }
}
__device__ __forceinline__ void conv8r_lds(const u32x4 (&rows)[4], const LAS float* w, int wstride, float (&o)[8]) {
#pragma unroll
    for (int e = 0; e < 8; ++e) o[e] = 0.f;
#pragma unroll
    for (int j = 0; j < 4; ++j) {
        const u32x4 v = rows[j];
        const f32x4 w0 = *(const LAS f32x4*)(w + j * wstride), w1 = *(const LAS f32x4*)(w + j * wstride + 4);
        o[0] += w0[0] * bflo(v.x); o[1] += w0[1] * bfhi(v.x); o[2] += w0[2] * bflo(v.y); o[3] += w0[3] * bfhi(v.y);
        o[4] += w1[0] * bflo(v.z); o[5] += w1[1] * bfhi(v.z); o[6] += w1[2] * bflo(v.w); o[7] += w1[3] * bfhi(v.w);
    }
}
__device__ __forceinline__ void gdn_prep_load(const Ctx& a, int it, int tid, u32x4 (&rq)[4], u32x4 (&rk)[4], u32x4 (&rv)[4], float& gl_, float& bl_) {
    const int bh = it >> 5, n = it & 31, b = bh >> 2, h = bh & 3, tok = tid >> 3, cg_ = tid & 7, s = 64 * n + tok;
    const bf16_t* p = (const bf16_t*)(a.ws + WS_PROJ) + (size_t)(b * NS + s) * NDINP + h * 64 + 8 * cg_;
#pragma unroll
    for (int j = 0; j < 4; ++j) { const int d = 3 - j;
        if (s - d >= 0) { const bf16_t* r = p - (size_t)d * NDINP; rq[j] = *(const u32x4*)r; rk[j] = *(const u32x4*)(r + 256); rv[j] = *(const u32x4*)(r + 512); }
        else { rq[j] = (u32x4){0u, 0u, 0u, 0u}; rk[j] = rq[j]; rv[j] = rq[j]; } }
    const size_t gi = ((size_t)(b * NS + 64 * n + (tid & 63))) * 4 + h;
    gl_ = ((const float*)(a.ws + WS_G))[gi]; bl_ = ((const float*)(a.ws + WS_BETA))[gi];
}

__device__ __forceinline__ void rglru_item(const Ctx& a, int l, int item, LAS unsigned char* lds) {
    const int tid = opaque_tid(a.wid), lane = tid & 63, w = tid >> 6, fr = lane & 15, fq = lane >> 4;
    const int b = item >> 3, g = item & 7;
    const bf16_t* PROJ = (const bf16_t*)(a.ws + WS_PROJ);
    bf16_t* MIX = (bf16_t*)(a.ws + WS_U);
    LAS bf16_t* XCb = (LAS bf16_t*)lds;
    LAS bf16_t* WaT = (LAS bf16_t*)(lds + 18432);
    LAS bf16_t* WxT = (LAS bf16_t*)(lds + 18432 + 9216);
    LAS float* SEG = (LAS float*)(lds + 36864);
    for (int idx = tid; idx < 4096; idx += NTHREADS) { const int i = idx >> 6, j = idx & 63;
        WaT[j * 72 + i] = f2bf(inp(a, 13)[(((size_t)l * 8 + g) * 64 + i) * 64 + j]);
        WxT[j * 72 + i] = f2bf(inp(a, 15)[(((size_t)l * 8 + g) * 64 + i) * 64 + j]); }
    float ba[4], bx[4], sp8[4], hc[4];
#pragma unroll
    for (int cb = 0; cb < 4; ++cb) { const int ch = l * 512 + g * 64 + 16 * cb + fr; ba[cb] = inp(a, 14)[ch]; bx[cb] = inp(a, 16)[ch]; sp8[cb] = -8.0f * softplusf_(-inp(a, 17)[ch]); hc[cb] = 0.f; }
    const int cg_ = tid & 7;
    const float* cw = inp(a, 11) + (size_t)l * 4 * 512 + g * 64 + 8 * cg_;
    float cbias[8];
#pragma unroll
    for (int e = 0; e < 8; ++e) cbias[e] = inp(a, 12)[l * 512 + g * 64 + 8 * cg_ + e];
    u32x4 crow[2][4], nrow[2][4];
#define RG_LOADROWS(dst, scx) do { _Pragma("unroll") for (int jj = 0; jj < 2; ++jj) { const int s_ = 128 * (scx) + (tid >> 3) + 64 * jj; \
        const bf16_t* p_ = PROJ + ((size_t)(b * NS + s_)) * NDINP + 1024 + g * 64 + 8 * cg_; \
        _Pragma("unroll") for (int j = 0; j < 4; ++j) { const int d_ = 3 - j; dst[jj][j] = (s_ - d_ >= 0) ? *(const u32x4*)(p_ - (size_t)d_ * NDINP) : (u32x4){0u, 0u, 0u, 0u}; } } } while (0)
    RG_LOADROWS(crow, 0);
    for (int sc = 0; sc < 16; ++sc) {
        __syncthreads();
#pragma unroll
        for (int jj = 0; jj < 2; ++jj) {
            const int tok = (tid >> 3) + 64 * jj;
            float o[8]; conv8r(crow[jj], cw, 512, o);
            u32x4 wv; wv.x = cvt_pk_bf16(o[0] + cbias[0], o[1] + cbias[1]); wv.y = cvt_pk_bf16(o[2] + cbias[2], o[3] + cbias[3]);
            wv.z = cvt_pk_bf16(o[4] + cbias[4], o[5] + cbias[5]); wv.w = cvt_pk_bf16(o[6] + cbias[6], o[7] + cbias[7]);
            *(LAS u32x4*)(XCb + tok * 72 + 8 * cg_) = wv;
        }
        __syncthreads();
        { const int scn = (sc + 1 < 16) ? sc + 1 : sc; RG_LOADROWS(nrow, scn); }
        unsigned short gate16[4][4];
        { const size_t tokb = (size_t)(b * NS + 128 * sc + 16 * w + 4 * fq);
#pragma unroll
          for (int cb = 0; cb < 4; ++cb)
#pragma unroll
            for (int r = 0; r < 4; ++r) gate16[cb][r] = PROJ[(tokb + r) * NDINP + 1536 + g * 64 + 16 * cb + fr]; }
        bf16x8 af[2];
#pragma unroll
        for (int ks = 0; ks < 2; ++ks) af[ks] = *(const LAS bf16x8*)(XCb + (16 * w + fr) * 72 + 32 * ks + 8 * fq);
        float cum[4][4], hl[4][4];
#pragma unroll
        for (int cb = 0; cb < 4; ++cb) {
            f32x4 da = {0.f, 0.f, 0.f, 0.f}, dx = {0.f, 0.f, 0.f, 0.f};
#pragma unroll
            for (int ks = 0; ks < 2; ++ks) {
                const bf16x8 wa = *(const LAS bf16x8*)(WaT + (16 * cb + fr) * 72 + 32 * ks + 8 * fq);
                const bf16x8 wx = *(const LAS bf16x8*)(WxT + (16 * cb + fr) * 72 + 32 * ks + 8 * fq);
                da = mfma16(af[ks], wa, da); dx = mfma16(af[ks], wx, dx);
            }
            float pa = 1.f, ph = 0.f;
#pragma unroll
            for (int r = 0; r < 4; ++r) {
                const float xc = bf2f(XCb[(16 * w + 4 * fq + r) * 72 + 16 * cb + fr]);
                const float rr = sigmoidf_(da[r] + ba[cb]), ii = sigmoidf_(dx[r] + bx[cb]);
                const float la = sp8[cb] * rr;
                const float av = __expf(la), x2 = 2.0f * la;
                const float em = (x2 > -0.1f) ? -x2 * (1.0f + x2 * (0.5f + x2 * (0.16666667f + x2 * 0.041666668f))) : 1.0f - av * av;
                const float mult = __builtin_amdgcn_sqrtf(em);
                const float bt = mult * ii * xc;
                pa *= av; ph = av * ph + bt;
                cum[cb][r] = pa; hl[cb][r] = ph;
            }
        }
        float pre_a[4], pre_h[4], tot_a[4], tot_h[4];
#pragma unroll
        for (int cb = 0; cb < 4; ++cb) {
            float ea = 1.f, eh = 0.f, ta = 1.f, th = 0.f;
#pragma unroll
            for (int q = 0; q < 4; ++q) {
                const float qa = shl_(cum[cb][3], fr + 16 * q), qh = shl_(hl[cb][3], fr + 16 * q);
                if (q < fq) { eh = qa * eh + qh; ea *= qa; }
                th = qa * th + qh; ta *= qa;
            }
            pre_a[cb] = ea; pre_h[cb] = eh; tot_a[cb] = ta; tot_h[cb] = th;
        }
        LAS float* seg = SEG + (sc & 1) * (8 * 64 * 2);
        if (fq == 0) {
#pragma unroll
            for (int cb = 0; cb < 4; ++cb) *(LAS f32x2*)(seg + (w * 64 + 16 * cb + fr) * 2) = (f32x2){tot_a[cb], tot_h[cb]};
        }
        __syncthreads();
        const int tok0 = b * NS + 128 * sc + 16 * w + 4 * fq;
#pragma unroll
        for (int cb = 0; cb < 4; ++cb) {
            float h_in = hc[cb], h_all = hc[cb];
#pragma unroll
            for (int w2 = 0; w2 < 8; ++w2) { const f32x2 t = *(const LAS f32x2*)(seg + (w2 * 64 + 16 * cb + fr) * 2);
                h_all = t.x * h_all + t.y; if (w2 < w) h_in = h_all; }
            hc[cb] = h_all;
            const float h0 = pre_a[cb] * h_in + pre_h[cb];
#pragma unroll
            for (int r = 0; r < 4; ++r) {
                const float h = hl[cb][r] + cum[cb][r] * h0;
                const size_t tok = (size_t)(tok0 + r);
                const float gt = bf2f(gate16[cb][r]);
                const float y = 0.7978845608028654f * (gt + 0.044715f * gt * gt * gt);
                const float th = 1.0f - 2.0f * __builtin_amdgcn_rcpf(1.0f + __expf(2.0f * y));
                MIX[tok * ND + 256 + g * 64 + 16 * cb + fr] = f2bf(h * 0.5f * gt * (1.0f + th));
            }
        }
#pragma unroll
        for (int jj = 0; jj < 2; ++jj)
#pragma unroll
            for (int j = 0; j < 4; ++j) crow[jj][j] = nrow[jj][j];
    }
#undef RG_LOADROWS
}

__device__ __forceinline__ void gdn_prep_item(const Ctx& a, int l, int it, LAS unsigned char* lds, const u32x4 (&rq)[4], const u32x4 (&rk)[4], const u32x4 (&rv)[4], const float g_lane, const float b_lane) {
    const int tid = opaque_tid(a.wid), lane = tid & 63, w = tid >> 6, fr = lane & 15, fq = lane >> 4;
    const int bh = it >> 5, n = it & 31, b = bh >> 2, h = bh & 3;
    const bf16_t* PROJ = (const bf16_t*)(a.ws + WS_PROJ);
    const float* Gg = (const float*)(a.ws + WS_G); const float* Bg = (const float*)(a.ws + WS_BETA);
    bf16_t* Wg = (bf16_t*)(a.ws + WS_GDN) + (size_t)it * 4096; bf16_t* QDg = Wg + GDN_ARR; bf16_t* QKg = QDg + GDN_ARR; bf16_t* KTTg = QKg + GDN_ARR; bf16_t* UTg = KTTg + GDN_ARR;
    float* CDg = (float*)(a.ws + WS_CD);
    LAS bf16_t* Qs = (LAS bf16_t*)lds;
    LAS bf16_t* Ks = (LAS bf16_t*)(lds + 9216);
    LAS bf16_t* KBs = (LAS bf16_t*)(lds + 18432);
    LAS float* R = (LAS float*)(lds + 27648);
    LAS float* Ls = (LAS float*)(lds + 27648 + 33280);
    LAS float* gcs = (LAS float*)(lds + 27648 + 33280 + 16384);
    LAS float* bts = gcs + 64;
    const int tok = tid >> 3, cg_ = tid & 7, s = 64 * n + tok;
    const size_t trow = (size_t)(b * NS + s);
    float q8[8], k8[8], v8[8];
    {
        const LAS float* cw = (const LAS float*)(lds + 80 * 1024) + h * 768 + 8 * cg_;
        conv8r_lds(rq, cw, 192, q8); conv8r_lds(rk, cw + 64, 192, k8); conv8r_lds(rv, cw + 128, 192, v8);
        float sq = 0.f, sk = 0.f;
#pragma unroll
        for (int e = 0; e < 8; ++e) { q8[e] = siluf_(q8[e]); k8[e] = siluf_(k8[e]); v8[e] = siluf_(v8[e]); sq += q8[e] * q8[e]; sk += k8[e] * k8[e]; }
        sq += dpp_xor1(sq); sq += dpp_xor2(sq); sq += dpp_hmirror(sq);
        sk += dpp_xor1(sk); sk += dpp_xor2(sk); sk += dpp_hmirror(sk);
        const float rq = rsqrtf(sq + EPS) * 0.125f, rk = rsqrtf(sk + EPS);
#pragma unroll
        for (int e = 0; e < 8; ++e) { q8[e] *= rq; k8[e] *= rk; }
    }
    float gv = g_lane;
#pragma unroll
    for (int o = 1; o < 64; o <<= 1) { const float t = shl_(gv, (lane - o) & 63); if (lane >= o) gv += t; }
    __syncthreads();
    if (w == 0) { gcs[lane] = gv; bts[lane] = b_lane; }
    {
        const float gc = shl_(gv, tok & 63), gl = shl_(gv, 63), bt = shl_(b_lane, tok & 63);
        const float eg = __expf(gc), et = __expf(gl - gc);
        u32x4 wq, wk, wkb, wqd;
        wq.x = cvt_pk_bf16(q8[0], q8[1]); wq.y = cvt_pk_bf16(q8[2], q8[3]); wq.z = cvt_pk_bf16(q8[4], q8[5]); wq.w = cvt_pk_bf16(q8[6], q8[7]);
        wk.x = cvt_pk_bf16(k8[0], k8[1]); wk.y = cvt_pk_bf16(k8[2], k8[3]); wk.z = cvt_pk_bf16(k8[4], k8[5]); wk.w = cvt_pk_bf16(k8[6], k8[7]);
        wkb.x = cvt_pk_bf16(k8[0] * bt, k8[1] * bt); wkb.y = cvt_pk_bf16(k8[2] * bt, k8[3] * bt); wkb.z = cvt_pk_bf16(k8[4] * bt, k8[5] * bt); wkb.w = cvt_pk_bf16(k8[6] * bt, k8[7] * bt);
        wqd.x = cvt_pk_bf16(q8[0] * eg, q8[1] * eg); wqd.y = cvt_pk_bf16(q8[2] * eg, q8[3] * eg); wqd.z = cvt_pk_bf16(q8[4] * eg, q8[5] * eg); wqd.w = cvt_pk_bf16(q8[6] * eg, q8[7] * eg);
        *(LAS u32x4*)(Qs + tok * 72 + 8 * cg_) = wq; *(LAS u32x4*)(Ks + tok * 72 + 8 * cg_) = wk; *(LAS u32x4*)(KBs + tok * 72 + 8 * cg_) = wkb;
        *(u32x4*)(QDg + tok * 64 + 8 * cg_) = wqd;
#pragma unroll
        for (int e = 0; e < 8; ++e) { R[tok * 129 + 8 * cg_ + e] = v8[e] * bt; R[tok * 129 + 64 + 8 * cg_ + e] = k8[e] * bt * eg; KTTg[(8 * cg_ + e) * 64 + tok] = f2bf(k8[e] * et); }
        if (tid == 0) CDg[it] = __expf(gl);
    }
    __syncthreads();
    {
        const int mat = w >> 2, rb = w & 3;
        const LAS bf16_t* As = mat ? Qs : KBs;
        bf16x8 bf_[2];
#pragma unroll
        for (int ks = 0; ks < 2; ++ks) bf_[ks] = *(const LAS bf16x8*)(As + (16 * rb + fr) * 72 + 32 * ks + 8 * fq);
        const int i = 16 * rb + fr; const float gci = gcs[i];
#pragma unroll
        for (int cb = 0; cb < 4; ++cb) {
            f32x4 d = {0.f, 0.f, 0.f, 0.f};
            if (cb <= rb) {
#pragma unroll
                for (int ks = 0; ks < 2; ++ks) { const bf16x8 kf = *(const LAS bf16x8*)(Ks + (16 * cb + fr) * 72 + 32 * ks + 8 * fq); d = mfma16(kf, bf_[ks], d); }
#pragma unroll
                for (int r = 0; r < 4; ++r) { const int j = 16 * cb + 4 * fq + r; const bool keep = mat ? (i >= j) : (i > j);
                    d[r] = keep ? d[r] * __expf(gci - gcs[j]) : 0.f; }
            }
            if (mat == 0) { if (cb <= rb) *(LAS f32x4*)(Ls + i * 64 + 16 * cb + 4 * fq) = d; }
            else { u32x2 o; o.x = cvt_pk_bf16(d[0], d[1]); o.y = cvt_pk_bf16(d[2], d[3]); *(u32x2*)(QKg + i * 64 + 16 * cb + 4 * fq) = o; }
        }
    }
    __syncthreads();
    {
        const int c = lane >> 2, p = lane & 3, col = 16 * w + c;
        float xs[4][4];
#pragma unroll
        for (int I = 0; I < 4; ++I) {
            if (I > 0) {
                f32x4 d = {0.f, 0.f, 0.f, 0.f};
#pragma unroll
                for (int J = 0; J < I; ++J)
#pragma unroll
                    for (int s2 = 0; s2 < 4; ++s2) {
                        const float av = Ls[(16 * I + fr) * 64 + 16 * J + 4 * s2 + fq];
                        const float bv = R[(16 * J + 4 * s2 + fq) * 129 + 16 * w + fr];
                        d = __builtin_amdgcn_mfma_f32_16x16x4f32(av, bv, d, 0, 0, 0);
                    }
#pragma unroll
                for (int r = 0; r < 4; ++r) R[(16 * I + 4 * fq + r) * 129 + 16 * w + fr] -= d[r];
            }
#pragma unroll
            for (int jj = 0; jj < 4; ++jj) xs[I][jj] = 0.f;
#pragma unroll
            for (int sb = 0; sb < 4; ++sb) {
                f32x4 Lv[4]; float rhs[4], tot[4];
#pragma unroll
                for (int r = 0; r < 4; ++r) { Lv[r] = *(const LAS f32x4*)(Ls + (16 * I + 4 * sb + r) * 64 + 16 * I + 4 * p); rhs[r] = R[(16 * I + 4 * sb + r) * 129 + col]; }
#pragma unroll
                for (int r = 0; r < 4; ++r) { float part = (p < sb) ? (Lv[r][0] * xs[I][0] + Lv[r][1] * xs[I][1]) + (Lv[r][2] * xs[I][2] + Lv[r][3] * xs[I][3]) : 0.f;
                    part += dpp_xor1(part); part += dpp_xor2(part); tot[r] = rhs[r] - part; }
                const float x0 = tot[0];
                const float x1 = tot[1] - Lv[1][0] * x0;
                const float x2 = tot[2] - (Lv[2][0] * x0 + Lv[2][1] * x1);
                const float x3 = tot[3] - (Lv[3][0] * x0 + Lv[3][1] * x1 + Lv[3][2] * x2);
                if (p == sb) { xs[I][0] = x0; xs[I][1] = x1; xs[I][2] = x2; xs[I][3] = x3;
                    R[(16 * I + 4 * sb + 0) * 129 + col] = x0; R[(16 * I + 4 * sb + 1) * 129 + col] = x1; R[(16 * I + 4 * sb + 2) * 129 + col] = x2; R[(16 * I + 4 * sb + 3) * 129 + col] = x3; }
            }
        }
        if (w < 4) {
#pragma unroll
            for (int m = 0; m < 4; ++m) { u32x2 o; o.x = cvt_pk_bf16(xs[m][0], xs[m][1]); o.y = cvt_pk_bf16(xs[m][2], xs[m][3]); *(u32x2*)(UTg + col * 64 + 16 * m + 4 * p) = o; }
        } else {
#pragma unroll
            for (int m = 0; m < 4; ++m)
#pragma unroll
                for (int j = 0; j < 4; ++j) Wg[(16 * m + 4 * p + j) * 64 + (col - 64)] = f2bf(xs[m][j]);
        }
    }
}

__device__ __forceinline__ void gdn_scan_item(const Ctx& a, int l, int bh, LAS unsigned char* lds) {
    const int tid = opaque_tid(a.wid), lane = tid & 63, w = tid >> 6, fr = lane & 15, fq = lane >> 4;
    const int es = w & 3, ih = w >> 2, b = bh >> 2, h = bh & 3;
    const bf16_t* PROJ = (const bf16_t*)(a.ws + WS_PROJ);
    bf16_t* MIX = (bf16_t*)(a.ws + WS_U);
    const float* CDg = (const float*)(a.ws + WS_CD);
    LAS bf16_t* STs = (LAS bf16_t*)lds;
    LAS bf16_t* VNs = (LAS bf16_t*)(lds + 9216);
    LAS float* SS = (LAS float*)(lds + 18432);
    for (int i = tid; i < 9216 / 4; i += NTHREADS) ((LAS unsigned*)STs)[i] = 0u;
    f32x4 stC[2] = {{0.f, 0.f, 0.f, 0.f}, {0.f, 0.f, 0.f, 0.f}};
    const float ng = inp(a, 10)[l * 64 + 16 * es + fr];
    bf16_t* mixp = MIX + ((size_t)(b * NS + 32 * ih + 4 * fq)) * ND + h * 64 + 16 * es + fr;
    __syncthreads();
    bf16x8 wf[2][2], qdf[2][2], qkf[2][2], ktf[2][2]; u32x2 uv[2]; float cd; unsigned short zz[2][4];
    bf16x8 nwf[2][2], nqdf[2][2], nqkf[2][2], nktf[2][2]; u32x2 nuv[2]; float ncd; unsigned short nzz[2][4];
    bf16x8 mwf[2][2]; u32x2 muv[2];
    unsigned offW[2], offU[2], offZ[2][4];
#pragma unroll
    for (int x = 0; x < 2; ++x) { offW[x] = (unsigned)(((16 * (2 * ih + x) + fr) * 64 + 8 * fq) * 2); offU[x] = (unsigned)(((16 * es + fr) * 64 + 16 * (2 * ih + x) + 4 * fq) * 2);
#pragma unroll
        for (int r = 0; r < 4; ++r) offZ[x][r] = (unsigned)(((16 * (2 * ih + x) + 4 * fq + r) * NDINP + 16 * es + fr) * 2); }
    const char* gdn_base = (const char*)(a.ws + WS_GDN);
    const char* z_base = (const char*)(a.ws + WS_PROJ) + ((size_t)b * NS * NDINP + 768 + h * 64) * 2;
#define SCAN_LOAD(W_, QD_, QK_, KT_, UV_, CD_, ZZ_, itx) do { \
        const char* bW_ = gdn_base + (size_t)(itx) * 8192; const char* bQD_ = bW_ + GDN_ARR * 2; const char* bQK_ = bQD_ + GDN_ARR * 2; const char* bKT_ = bQK_ + GDN_ARR * 2; const char* bU_ = bKT_ + GDN_ARR * 2; \
        const char* bZ_ = z_base + (size_t)(64 * ((itx) & 31)) * NDINP * 2; \
        _Pragma("unroll") for (int x = 0; x < 2; ++x) { \
            _Pragma("unroll") for (int ks = 0; ks < 2; ++ks) { W_[x][ks] = *(const bf16x8*)(bW_ + offW[x] + 64 * ks); QD_[x][ks] = *(const bf16x8*)(bQD_ + offW[x] + 64 * ks); \
                QK_[x][ks] = *(const bf16x8*)(bQK_ + offW[x] + 64 * ks); KT_[x][ks] = *(const bf16x8*)(bKT_ + offW[x] + 64 * ks); } \
            UV_[x] = *(const u32x2*)(bU_ + offU[x]); \
            _Pragma("unroll") for (int r = 0; r < 4; ++r) ZZ_[x][r] = *(const unsigned short*)(bZ_ + offZ[x][r]); } \
        CD_ = CDg[itx]; } while (0)
#define SCAN_LOAD_WU(W_, UV_, itx) do { const char* bW_ = gdn_base + (size_t)(itx) * 8192; const char* bU_ = bW_ + 4 * GDN_ARR * 2; \
        _Pragma("unroll") for (int x = 0; x < 2; ++x) { \
            _Pragma("unroll") for (int ks = 0; ks < 2; ++ks) W_[x][ks] = *(const bf16x8*)(bW_ + offW[x] + 64 * ks); \
            UV_[x] = *(const u32x2*)(bU_ + offU[x]); } } while (0)
    SCAN_LOAD(wf, qdf, qkf, ktf, uv, cd, zz, bh * 32);
    SCAN_LOAD_WU(mwf, muv, bh * 32 + 1);
    for (int n = 0; n < 32; ++n) {
        const int itn = bh * 32 + ((n + 1 < 32) ? n + 1 : n);
        SCAN_LOAD(nwf, nqdf, nqkf, nktf, nuv, ncd, nzz, itn);
#pragma unroll
        for (int x = 0; x < 2; ++x) { nuv[x] = muv[x];
#pragma unroll
            for (int ks = 0; ks < 2; ++ks) nwf[x][ks] = mwf[x][ks]; }
        { const int itm = bh * 32 + ((n + 2 < 32) ? n + 2 : 31); SCAN_LOAD_WU(mwf, muv, itm); }
        bf16x8 stf[2];
#pragma unroll
        for (int ks = 0; ks < 2; ++ks) stf[ks] = *(const LAS bf16x8*)(STs + (16 * es + fr) * 72 + 32 * ks + 8 * fq);
#pragma unroll
        for (int x = 0; x < 2; ++x) {
            f32x4 d = {0.f, 0.f, 0.f, 0.f};
#pragma unroll
            for (int ks = 0; ks < 2; ++ks) d = mfma16(wf[x][ks], stf[ks], d);
            const float v0 = bflo(uv[x].x) - d[0], v1 = bfhi(uv[x].x) - d[1], v2 = bflo(uv[x].y) - d[2], v3 = bfhi(uv[x].y) - d[3];
            u32x2 o; o.x = cvt_pk_bf16(v0, v1); o.y = cvt_pk_bf16(v2, v3);
            *(LAS u32x2*)(VNs + (16 * es + fr) * 72 + 16 * (2 * ih + x) + 4 * fq) = o;
        }
        __syncthreads();
        bf16x8 vnf[2];
#pragma unroll
        for (int ks = 0; ks < 2; ++ks) vnf[ks] = *(const LAS bf16x8*)(VNs + (16 * es + fr) * 72 + 32 * ks + 8 * fq);
        f32x4 o[2];
#pragma unroll
        for (int x = 0; x < 2; ++x) {
            f32x4 d = {0.f, 0.f, 0.f, 0.f};
#pragma unroll
            for (int ks = 0; ks < 2; ++ks) d = mfma16(qdf[x][ks], stf[ks], d);
#pragma unroll
            for (int ks = 0; ks < 2; ++ks) d = mfma16(qkf[x][ks], vnf[ks], d);
            o[x] = d;
#pragma unroll
            for (int r = 0; r < 4; ++r) { float sq = d[r] * d[r];
                sq += dpp_xor1(sq); sq += dpp_xor2(sq); sq += dpp_hmirror(sq); sq += dpp_rmirror(sq);
                if (fr == 0) SS[(16 * (2 * ih + x) + 4 * fq + r) * 4 + es] = sq; }
        }
#pragma unroll
        for (int x = 0; x < 2; ++x) {
            f32x4 d = stC[x] * cd;
#pragma unroll
            for (int ks = 0; ks < 2; ++ks) d = mfma16(vnf[ks], ktf[x][ks], d);
            stC[x] = d;
#pragma unroll
            for (int r = 0; r < 4; ++r) STs[(16 * es + 4 * fq + r) * 72 + 16 * (2 * ih + x) + fr] = f2bf(d[r]);
        }
        __syncthreads();
#pragma unroll
        for (int x = 0; x < 2; ++x)
#pragma unroll
            for (int r = 0; r < 4; ++r) {
                const int i = 16 * (2 * ih + x) + 4 * fq + r;
                const f32x4 ss = *(const LAS f32x4*)(SS + i * 4);
                const float rstd = __builtin_amdgcn_rsqf(((ss[0] + ss[1]) + (ss[2] + ss[3])) * (1.0f / 64.0f) + EPS);
                const float z = bf2f(zz[x][r]);
                mixp[(size_t)(16 * x + r) * ND] = f2bf(o[x][r] * rstd * ng * z * __builtin_amdgcn_rcpf(1.0f + __expf(-z)));
            }
        mixp += (size_t)64 * ND;
#pragma unroll
        for (int x = 0; x < 2; ++x) {
#pragma unroll
            for (int ks = 0; ks < 2; ++ks) { wf[x][ks] = nwf[x][ks]; qdf[x][ks] = nqdf[x][ks]; qkf[x][ks] = nqkf[x][ks]; ktf[x][ks] = nktf[x][ks]; }
            uv[x] = nuv[x];
#pragma unroll
            for (int r = 0; r < 4; ++r) zz[x][r] = nzz[x][r]; }
        cd = ncd;
    }
#undef SCAN_LOAD
#undef SCAN_LOAD_WU
}

__device__ __forceinline__ void attn_unit(const Ctx& a, int bh, int jq4, LAS unsigned char* lds) {
    const int tid = opaque_tid(a.wid), lane = tid & 63, w = tid >> 6, fr = lane & 15, fq = lane >> 4;
    const int b = bh >> 2, h = bh & 3;
    const bf16_t* QB = (const bf16_t*)(a.ws + WS_QB); const bf16_t* KB = (const bf16_t*)(a.ws + WS_KB); const bf16_t* VT = (const bf16_t*)(a.ws + WS_VT);
    bf16_t* MIX = (bf16_t*)(a.ws + WS_U);
    LAS unsigned char* Ks = lds;
    LAS unsigned char* Vs = lds + 13312;
    const int q0 = 256 * jq4;
    bf16x8 qf[2][3];
#pragma unroll
    for (int rb = 0; rb < 2; ++rb) { const bf16_t* qrow = QB + ((size_t)bh * NS + q0 + 32 * w + 16 * rb + fr) * 96 + 8 * fq;
#pragma unroll
      for (int ks = 0; ks < 3; ++ks) qf[rb][ks] = *(const bf16x8*)(qrow + 32 * ks); }
    float m_run[2] = {-INFINITY, -INFINITY}, l_part[2] = {0.f, 0.f};
    f32x4 o[2][4];
#pragma unroll
    for (int rb = 0; rb < 2; ++rb)
#pragma unroll
        for (int db = 0; db < 4; ++db) o[rb][db] = (f32x4){0.f, 0.f, 0.f, 0.f};
    const int ntile = 4 * jq4 + 4, my_nt = 4 * jq4 + 1 + (w >> 1);
    const unsigned char* kbase = (const unsigned char*)(KB + (size_t)bh * NS * 96);
    const bf16_t* vbase = VT + (size_t)bh * NS * 64;
    u32x4 kr0, kr1 = {0u, 0u, 0u, 0u}, vr;
    const int vd = tid >> 3, vc = tid & 7;
    kr0 = *(const u32x4*)(kbase + (size_t)tid * 16);
    if (tid < 256) kr1 = *(const u32x4*)(kbase + (size_t)(512 + tid) * 16);
    vr = *(const u32x4*)(vbase + (size_t)vd * 64 + 8 * vc);
    for (int tile = 0; tile < ntile; ++tile) {
        __syncthreads();
        { const int ch = tid; *(LAS u32x4*)(Ks + (ch / 12) * 208 + (ch % 12) * 16) = kr0; }
        if (tid < 256) { const int ch = 512 + tid; *(LAS u32x4*)(Ks + (ch / 12) * 208 + (ch % 12) * 16) = kr1; }
        *(LAS u32x4*)(Vs + vd * 160 + vc * 16) = vr;
        __syncthreads();
        if (tile + 1 < ntile) {
            const unsigned char* kt = kbase + (size_t)(tile + 1) * 64 * 192;
            kr0 = *(const u32x4*)(kt + (size_t)tid * 16);
            if (tid < 256) kr1 = *(const u32x4*)(kt + (size_t)(512 + tid) * 16);
            vr = *(const u32x4*)(vbase + (size_t)(64 * (tile + 1) + vd) * 64 + 8 * vc);
        }
        if (tile < my_nt) {
            f32x4 s[2][4];
#pragma unroll
            for (int kb = 0; kb < 4; ++kb) {
                f32x4 d0 = {0.f, 0.f, 0.f, 0.f}, d1 = {0.f, 0.f, 0.f, 0.f};
#pragma unroll
                for (int ks = 0; ks < 3; ++ks) { const bf16x8 kf = *(const LAS bf16x8*)(Ks + (16 * kb + fr) * 208 + 64 * ks + 16 * fq); d0 = mfma16(kf, qf[0][ks], d0); d1 = mfma16(kf, qf[1][ks], d1); }
                s[0][kb] = d0; s[1][kb] = d1;
            }
            bf16x8 pf[2][2];
#pragma unroll
            for (int rb = 0; rb < 2; ++rb) {
                float mx = fmaxf(fmaxf(fmaxf(s[rb][0][0], s[rb][0][1]), fmaxf(s[rb][0][2], s[rb][0][3])), fmaxf(fmaxf(s[rb][1][0], s[rb][1][1]), fmaxf(s[rb][1][2], s[rb][1][3])));
                mx = fmaxf(mx, fmaxf(fmaxf(fmaxf(s[rb][2][0], s[rb][2][1]), fmaxf(s[rb][2][2], s[rb][2][3])), fmaxf(fmaxf(s[rb][3][0], s[rb][3][1]), fmaxf(s[rb][3][2], s[rb][3][3]))));
                mx = fmaxf(mx, shx(mx, 16, lane)); mx = fmaxf(mx, shx(mx, 32, lane));
                if (__builtin_amdgcn_ballot_w64(mx > m_run[rb] + 8.0f) != 0ull) {
                    const float m_new = fmaxf(m_run[rb], mx);
                    const float al = __builtin_amdgcn_exp2f(m_run[rb] - m_new);
                    m_run[rb] = m_new; l_part[rb] *= al;
#pragma unroll
                    for (int db = 0; db < 4; ++db) o[rb][db] = o[rb][db] * al;
                }
                const float m_use = m_run[rb];
                float ps = 0.f;
#pragma unroll
                for (int kb = 0; kb < 4; ++kb)
#pragma unroll
                    for (int r = 0; r < 4; ++r) { s[rb][kb][r] = __builtin_amdgcn_exp2f(s[rb][kb][r] - m_use); ps += s[rb][kb][r]; }
                l_part[rb] += ps;
#pragma unroll
                for (int ks = 0; ks < 2; ++ks) {
                    u32x4 t; t.x = cvt_pk_bf16(s[rb][2 * ks][0], s[rb][2 * ks][1]); t.y = cvt_pk_bf16(s[rb][2 * ks][2], s[rb][2 * ks][3]);
                    t.z = cvt_pk_bf16(s[rb][2 * ks + 1][0], s[rb][2 * ks + 1][1]); t.w = cvt_pk_bf16(s[rb][2 * ks + 1][2], s[rb][2 * ks + 1][3]);
                    pf[rb][ks] = __builtin_bit_cast(bf16x8, t);
                }
            }
#pragma unroll
            for (int db = 0; db < 4; ++db) {
                f32x4 d0 = o[0][db], d1 = o[1][db];
#pragma unroll
                for (int ks = 0; ks < 2; ++ks) {
                    const LAS unsigned char* vp = Vs + (32 * ks + 4 * fq + (fr >> 2)) * 160 + (16 * db + 4 * (fr & 3)) * 2;
                    const s16x4 lo = __builtin_amdgcn_ds_read_tr16_b64_v4i16((LAS s16x4*)vp);
                    const s16x4 hi = __builtin_amdgcn_ds_read_tr16_b64_v4i16((LAS s16x4*)(vp + 16 * 160));
                    const bf16x8 va = __builtin_shufflevector(lo, hi, 0, 1, 2, 3, 4, 5, 6, 7);
                    d0 = mfma16(va, pf[0][ks], d0); d1 = mfma16(va, pf[1][ks], d1);
                }
                o[0][db] = d0; o[1][db] = d1;
            }
        }
    }
#pragma unroll
    for (int rb = 0; rb < 2; ++rb) {
        float lsum = l_part[rb]; lsum += shx(lsum, 16, lane); lsum += shx(lsum, 32, lane);
        const float inv = 1.0f / lsum;
        bf16_t* op = MIX + ((size_t)(b * NS + q0 + 32 * w + 16 * rb + fr)) * ND + 768 + h * 64 + 4 * fq;
#pragma unroll
        for (int db = 0; db < 4; ++db) { u32x2 t; t.x = cvt_pk_bf16(o[rb][db][0] * inv, o[rb][db][1] * inv); t.y = cvt_pk_bf16(o[rb][db][2] * inv, o[rb][db][3] * inv); *(u32x2*)(op + 16 * db) = t; }
    }
}

constexpr int N_PHASES = 18;
#ifndef PMASK
#define PMASK 0xFFFF
#endif
#define PM(k) (((PMASK) >> (k)) & 1)
#ifndef REPMASK
#define REPMASK 0
#endif
template <int PH, int REP>
__device__ __forceinline__ void phase_body(const KArgs& ka, LAS unsigned char* lds, const int wid0) {
    LAS unsigned* qslot = (LAS unsigned*)(lds + 140 * 1024);
    Ctx a; a.ws = ka.ws; a.out = ka.out; a.ka = &ka;
    a.bx = blockIdx.x; a.G = gridDim.x; a.wid = wid0;
    asm volatile("" : "+s"(a.bx), "+s"(a.G), "+s"(a.wid));
    const int G = a.G;
    unsigned char* ws = a.ws;
    float* MOD = (float*)(ws + WS_MOD);
    unsigned* ctl = (unsigned*)(ws + WS_CTL);
    constexpr int l = (PH - 1) >> 3, sub = (PH == 0) ? 8 : ((PH == N_PHASES - 1) ? 9 : ((PH - 1) & 7));
    const float* modl = MOD + (size_t)l * 16 * 6144;
    constexpr bool skipped = (sub == 5) || (sub == 0 && l == 1);
    if constexpr (skipped) return;
    if constexpr (sub == 8) { if (PM(0)) prologue_phase(a, lds); }
    else if constexpr (sub == 9) { if (PM(1)) final_norm_phase(a); }
    else if constexpr (sub == 0) { if (PM(2)) { norm_phase(a, inp(a, 0), inp(a, 5), modl, 0, 1024, true); } }
    else if constexpr (sub == 1) { if (PM(3)) {
        pg8::Gemm g{(const bf16_t*)(ws + (l == 0 ? WS_U : WS_HS)), (const bf16_t*)(ws + WS_WIN) + (size_t)l * NDINP * 1024, NT, NDINP, 1024, 1024, 1024};
        pg8::StaticOrder S; S.init(NT, NDINP, G, a.bx);
        pg8::EpiInProj<(l == 1)> E{ws, l};
        pg8::gemm_phase<pg8::EpiInProj<(l == 1)>>(lds, g, S, E, a.wid); } }
    else if constexpr (sub == 2) {
        if (PM(4)) {
        pg8::Gemm g{(const bf16_t*)(ws + WS_PROJ) + 2048, (const bf16_t*)(ws + WS_WMLA) + (size_t)l * 1024 * 384, NT, 1024, 384, NDINP, 384};
        pg8::StaticOrder S; S.init(NT, 1024, G, a.bx);
        pg8::EpiMLA E{ws};
        pg8::gemm_phase<pg8::EpiMLA>(lds, g, S, E, a.wid); }
        if (PM(6)) {
            const int ptid = opaque_tid(a.wid);
            { LAS float* cwl = (LAS float*)(lds + 80 * 1024);
              for (int idx = ptid; idx < 3072; idx += NTHREADS) { const int hh = idx / 768, rem = idx % 768, j = rem / 192, part = (rem % 192) >> 6, ch = rem & 63;
                  cwl[idx] = inp(a, 7)[((size_t)l * 4 + j) * 768 + part * 256 + hh * 64 + ch]; }
              __syncthreads(); }
            u32x4 rq[4], rk[4], rv[4]; float gl_ = 0.f, bl_ = 0.f;
            int it = a.bx;
            if (it < 2048) gdn_prep_load(a, it, ptid, rq, rk, rv, gl_, bl_);
            for (; it < 2048; it += a.G) {
                u32x4 nq[4], nk[4], nv[4]; float ngl, nbl;
                const int itn = (it + a.G < 2048) ? it + a.G : it;
                gdn_prep_load(a, itn, ptid, nq, nk, nv, ngl, nbl);
                gdn_prep_item(a, l, it, lds, rq, rk, rv, gl_, bl_);
#pragma unroll
                for (int j = 0; j < 4; ++j) { rq[j] = nq[j]; rk[j] = nk[j]; rv[j] = nv[j]; }
                gl_ = ngl; bl_ = nbl;
            }
        }
    } else if constexpr (sub == 3) {
        if (PM(7)) { if (a.bx < 64) gdn_scan_item(a, l, a.bx, lds); }
        unsigned* ctr = ctl + 64 * (2 * l + 1 + 4 * REP);
        constexpr int NQ = 128 + 512 + (l == 0 ? 84 : 0);
        for (;;) { const int u = q_pop(ctr, qslot, a.wid); if (u >= NQ) break;
            if (u < 128) { if (PM(5)) rglru_item(a, l, u, lds); } else if (u < 640) { if (PM(8)) attn_unit(a, (u - 128) & 63, 7 - ((u - 128) >> 6), lds); } else shw_item(a, lds, u - 640); }
    } else if constexpr (sub == 4) { if (PM(9)) {
        pg8::Gemm g{(const bf16_t*)(ws + WS_U), (const bf16_t*)(ws + WS_WOUT) + (size_t)l * 1024 * 1024, NT, 1024, 1024, 1024, 1024};
        pg8::StaticOrder S; S.init(NT, 1024, G, a.bx);
        pg8::EpiResid<true> E{(l == 0) ? inp(a, 0) : a.out, a.out, modl + 2048, inp(a, 23) + l * ND, modl + 4096, (bf16_t*)(ws + WS_HS), (float*)(ws + WS_SSQH)};
        pg8::gemm_phase<pg8::EpiResid<true>>(lds, g, S, E, a.wid); } }
    else if constexpr (sub == 7) { if (PM(9)) {
        pg8::Gemm g{(const bf16_t*)(ws + WS_HID), (const bf16_t*)(ws + WS_W2) + (size_t)l * 1024 * 4096, NT, 1024, NFF, NFF, NFF};
        pg8::StaticOrder S; S.init(NT, 1024, G, a.bx);
        pg8::EpiResid<(l == 0)> E{a.out, a.out, modl + 5120, inp(a, 5) + ND, MOD + (size_t)16 * 6144 + 1024, (bf16_t*)(ws + WS_HS), (float*)(ws + WS_SSQH)};
        pg8::gemm_phase<pg8::EpiResid<(l == 0)>>(lds, g, S, E, a.wid); } }
    else { if (PM(10)) {
        pg8::Gemm g{(const bf16_t*)(ws + WS_HS), (const bf16_t*)(ws + WS_W1) + (size_t)l * 4096 * 1024, NT, NFF, 1024, 1024, 1024};
        pg8::StaticOrder S; S.init(NT, NFF, G, a.bx);
        pg8::EpiRelu2<true> E{(bf16_t*)(ws + WS_HID), NFF, (const float*)(ws + WS_SSQH), (const float*)(ws + WS_SHW) + (size_t)(l == 0 ? 0 : 2) * 16 * 4096};
        pg8::gemm_phase<pg8::EpiRelu2<true>>(lds, g, S, E, a.wid); } }
    if (REP == 0 ? (((REPMASK) >> sub) & 1) || (PH + 1 < ka.ph_hi) : (PH + 1 < ka.ph_hi)) grid_bar((unsigned*)(ws + WS_BAR), a.G, a.wid, (volatile LAS unsigned*)(lds + 142 * 1024));
}
template <int PH>
__device__ __forceinline__ void run_phase(const KArgs& ka, LAS unsigned char* lds, const int wid0) {
    constexpr int sub = (PH == 0) ? 8 : ((PH == N_PHASES - 1) ? 9 : ((PH - 1) & 7));
    phase_body<PH, 0>(ka, lds, wid0);
    if constexpr (((REPMASK) >> sub) & 1) phase_body<PH, 1>(ka, lds, wid0);
}

__global__ void __launch_bounds__(NTHREADS, 2) mk_fwd(KArgs ka) {
    extern __shared__ __attribute__((aligned(16))) unsigned char lds_raw[];
    LAS unsigned char* lds = (LAS unsigned char*)lds_raw;
    cg::grid_group grid = cg::this_grid();
    if (ka.ph_lo < -7) grid.sync();
    const int wid0 = __builtin_amdgcn_readfirstlane((int)(threadIdx.x >> 6));
    if (threadIdx.x == 0) { ((volatile LAS unsigned*)(lds + 142 * 1024))[0] = 0u; ((volatile LAS unsigned*)(lds + 142 * 1024))[1] = 0u;
        (void)xb_add(&((unsigned*)(ka.ws + WS_BAR))[XB_XCNT(xb_xcc_id())], 1u); }
    __syncthreads();
#define RUNP(k) if (ka.ph_lo <= (k) && (k) < ka.ph_hi) run_phase<k>(ka, lds, wid0);
    RUNP(0) RUNP(1) RUNP(2) RUNP(3) RUNP(4) RUNP(5) RUNP(6) RUNP(7) RUNP(8) RUNP(9) RUNP(10) RUNP(11) RUNP(12) RUNP(13) RUNP(14) RUNP(15) RUNP(16) RUNP(17)
#undef RUNP
}

#ifdef DBG_STOP
__global__ void dbg_hash(const unsigned char* ws, float* out) {
    __shared__ unsigned hs;
    const int item = blockIdx.x; if (threadIdx.x == 0) hs = 0u; __syncthreads();
    unsigned h = 0u;
    const bf16_t* Gd = (const bf16_t*)(ws + WS_GDN);
    for (int k = threadIdx.x; k < 5 * 4096; k += blockDim.x) { const unsigned v = Gd[(size_t)(k >> 12) * GDN_ARR + (size_t)item * 4096 + (k & 4095)]; h += (v + 1u) * ((unsigned)k * 2654435761u + 12345u); }
    if (threadIdx.x == 0) h += __float_as_uint(((const float*)(ws + WS_CD))[item]) * 7919u;
    atomicAdd(&hs, h); __syncthreads();
    const float f = (float)(hs >> 8) * (1.0f / 65536.0f);
    for (int k = threadIdx.x; k < 16384; k += blockDim.x) out[(size_t)item * 16384 + k] = f;
}
__global__ void dbg_dump(const unsigned char* ws, float* out, int which) {
    const size_t i = (size_t)blockIdx.x * blockDim.x + threadIdx.x; if (i >= (size_t)NT * ND) return;
    const size_t t = i >> 10, c = i & 1023; float v = 0.f;
    if (which == 1) v = bf2f(((const bf16_t*)(ws + WS_U))[i]);
    else if (which == 2) { const bf16_t* P = (const bf16_t*)(ws + WS_PROJ) + t * NDINP; v = bf2f(P[c]) + 2.f * bf2f(P[c + 1024]) + 3.f * bf2f(P[2048 + (c & 511)]);
        v += ((const float*)(ws + WS_G))[t * 4 + (c & 3)] + ((const float*)(ws + WS_BETA))[t * 4 + (c & 3)] + 1e-3f * ((const float*)(ws + WS_SSQ))[t * 8 + (c & 7)]; }
    else if (which == 3) { v = bf2f(((const bf16_t*)(ws + WS_QB))[(t * 4 + (c >> 8)) * 96 + (c & 255) % 96]) + bf2f(((const bf16_t*)(ws + WS_KB))[(t * 4 + (c >> 8)) * 96 + (c & 255) % 96]) + bf2f(((const bf16_t*)(ws + WS_VT))[t * 256 + (c & 255)]); }
    else if (which == 4) { const bf16_t* Gd = (const bf16_t*)(ws + WS_GDN); v = bf2f(Gd[i % GDN_ARR]) + bf2f(Gd[GDN_ARR + i % GDN_ARR]) + bf2f(Gd[2 * GDN_ARR + i % GDN_ARR]) + bf2f(Gd[3 * GDN_ARR + i % GDN_ARR]) + bf2f(Gd[4 * GDN_ARR + i % GDN_ARR]); }
    else if (which == 5) v = bf2f(((const bf16_t*)(ws + WS_U))[i]);
    else if (which == 6) { v = bf2f(((const bf16_t*)(ws + WS_QB))[(t * 4 + (c >> 8)) * 96 + (c & 255) % 96]) + bf2f(((const bf16_t*)(ws + WS_KB))[(t * 4 + (c >> 8)) * 96 + (c & 255) % 96]) + bf2f(((const bf16_t*)(ws + WS_VT))[t * 256 + (c & 255)]);
        const bf16_t* Gd = (const bf16_t*)(ws + WS_GDN); v += bf2f(Gd[i % GDN_ARR]) + bf2f(Gd[GDN_ARR + i % GDN_ARR]) + bf2f(Gd[2 * GDN_ARR + i % GDN_ARR]) + bf2f(Gd[3 * GDN_ARR + i % GDN_ARR]) + bf2f(Gd[4 * GDN_ARR + i % GDN_ARR]);
        v += bf2f(((const bf16_t*)(ws + WS_U))[t * 1024 + 256 + (c & 511)]); }
    out[i] = v;
}
#endif
extern "C" void kernel_launch(void* const* d_in, const int* in_sizes, int n_in, void* d_out, int out_size, void* d_ws, size_t ws_size, hipStream_t stream) {
    static int grid = 0;
    if (grid == 0) {
        if (n_in != 27 || out_size != NT * ND || ws_size < WS_END) { fprintf(stderr, "kernel_launch: unexpected shapes (n_in %d out %d ws %zu)\n", n_in, out_size, ws_size); grid = -1; return; }
        int dev = 0, cus = 0, per_cu = 0;
        (void)hipGetDevice(&dev);
        (void)hipDeviceGetAttribute(&cus, hipDeviceAttributeMultiprocessorCount, dev);
        if (hipFuncSetAttribute((const void*)mk_fwd, hipFuncAttributeMaxDynamicSharedMemorySize, LDS_BYTES) != hipSuccess) { fprintf(stderr, "kernel_launch: hipFuncSetAttribute failed\n"); grid = -1; return; }
        if (hipOccupancyMaxActiveBlocksPerMultiprocessor(&per_cu, (const void*)mk_fwd, NTHREADS, LDS_BYTES) != hipSuccess || per_cu < 1) { fprintf(stderr, "kernel_launch: occupancy query says %d\n", per_cu); per_cu = 1; }
        (void)hipGetLastError();
        grid = cus;
    }
    if (grid < 0) return;
    if (hipMemsetAsync((char*)d_ws + WS_BAR, 0, XCD_BAR_WORDS * 4, stream) != hipSuccess) { fprintf(stderr, "kernel_launch: memset failed\n"); return; }
    KArgs a{};
    for (int i = 0; i < 27; ++i) a.in[i] = (const float*)d_in[i];
    a.out = (float*)d_out; a.ws = (unsigned char*)d_ws;
#ifdef DBG_STOP
    const int nl = DBG_STOP + 1;
#else
    const int nl = MK_N_LAUNCHES;
#endif
    for (int li = 0; li < nl; ++li) {
        a.ph_lo = (nl == 1) ? 0 : li; a.ph_hi = (nl == 1) ? N_PHASES : li + 1;
        void* args[] = {&a};
        hipError_t e = hipLaunchCooperativeKernel((const void*)mk_fwd, dim3(grid), dim3(NTHREADS), args, LDS_BYTES, stream);
        if (e != hipSuccess) { fprintf(stderr, "kernel_launch: cooperative launch failed: %s (grid %d)\n", hipGetErrorString(e), grid); break; }
    }
#if defined(DBG_DUMP) && DBG_DUMP == 7
    dbg_hash<<<2048, 256, 0, stream>>>((const unsigned char*)d_ws, (float*)d_out);
#elif defined(DBG_DUMP)
    dbg_dump<<<(NT * ND) / 256, 256, 0, stream>>>((const unsigned char*)d_ws, (float*)d_out, DBG_DUMP);
#endif
}
```

```cpp
#include <hip/hip_runtime.h>
#include <hip/hip_cooperative_groups.h>
#include <cstdio>
#include <cstdint>
namespace cg = cooperative_groups;

#ifndef MK_N_LAUNCHES
#define MK_N_LAUNCHES 1
#endif

#define LAS __attribute__((address_space(3)))
typedef unsigned short bf16_t;
typedef short bf16x8 __attribute__((ext_vector_type(8)));
typedef short s16x4 __attribute__((ext_vector_type(4)));
typedef float f32x4 __attribute__((ext_vector_type(4)));
typedef float f32x2 __attribute__((ext_vector_type(2)));
typedef unsigned u32x4 __attribute__((ext_vector_type(4)));
typedef unsigned u32x2 __attribute__((ext_vector_type(2)));

constexpr int NB = 16, NS = 2048, ND = 1024, NT = NB * NS, NDIN = 2472, NDINP = 2560, NFF = 4096;
constexpr float EPS = 1e-6f;
constexpr int NWAVES = 8, NTHREADS = 512;
constexpr int LDS_BYTES = 147456;

constexpr size_t MiB = 1u << 20;
constexpr size_t WS_CTL = 0;
constexpr size_t WS_BAR = 64 * 1024;
constexpr size_t WS_MOD = 1 * MiB;
constexpr size_t WS_COS = 2 * MiB;
constexpr size_t WS_SIN = 4 * MiB;
constexpr size_t WS_G = 6 * MiB;
constexpr size_t WS_BETA = 6 * MiB + 512 * 1024;
constexpr size_t WS_SSQ = 56 * MiB;
constexpr size_t WS_CD = 7 * MiB + 512 * 1024;
constexpr size_t WS_SMALL = 7 * MiB + 768 * 1024;
constexpr size_t WS_WIN = 8 * MiB;
constexpr size_t WS_WMLA = 18 * MiB;
constexpr size_t WS_WOUT = 20 * MiB;
constexpr size_t WS_W1 = 24 * MiB;
constexpr size_t WS_W2 = 40 * MiB;
constexpr size_t WS_U = 64 * MiB;
constexpr size_t WS_PROJ = 128 * MiB;
constexpr size_t WS_GDN = 288 * MiB;
constexpr size_t WS_VT = 368 * MiB;
constexpr size_t WS_QB = 384 * MiB;
constexpr size_t WS_KB = 408 * MiB;
constexpr size_t WS_HID = 128 * MiB;
constexpr size_t WS_HS = 432 * MiB;
constexpr size_t WS_SSQH = 57 * MiB;
constexpr size_t WS_SHW = 60 * MiB;
constexpr size_t WS_END = 496 * MiB;
constexpr size_t GDN_ARR = (size_t)2048 * 4096;

__device__ __forceinline__ float bf2f(unsigned short b) { return __uint_as_float(((unsigned)b) << 16); }
__device__ __forceinline__ float bflo(unsigned v) { return __uint_as_float(v << 16); }
__device__ __forceinline__ float bfhi(unsigned v) { return __uint_as_float(v & 0xffff0000u); }
typedef __bf16 bf16x2_t __attribute__((ext_vector_type(2)));
__device__ __forceinline__ unsigned cvt_pk_bf16(float lo, float hi) { const f32x2 v = {lo, hi}; return __builtin_bit_cast(unsigned, __builtin_convertvector(v, bf16x2_t)); }
__device__ __forceinline__ unsigned short f2bf(float f) { return (unsigned short)(cvt_pk_bf16(f, 0.f) & 0xffffu); }
__device__ __forceinline__ float sigmoidf_(float x) { return __builtin_amdgcn_rcpf(1.0f + __expf(-x)); }
__device__ __forceinline__ float siluf_(float x) { return x * sigmoidf_(x); }
__device__ __forceinline__ float softplusf_(float x) { return x > 20.f ? x : log1pf(__expf(x)); }
__device__ __forceinline__ float shx(float v, int mask, int lane) { return __builtin_bit_cast(float, __builtin_amdgcn_ds_bpermute((lane ^ mask) << 2, __builtin_bit_cast(int, v))); }
__device__ __forceinline__ float shl_(float v, int src) { return __builtin_bit_cast(float, __builtin_amdgcn_ds_bpermute(src << 2, __builtin_bit_cast(int, v))); }
__device__ __forceinline__ float wave_sum(float v, int lane) {
#pragma unroll
    for (int o = 1; o < 64; o <<= 1) v += shx(v, o, lane);
    return v;
}
__device__ __forceinline__ float dpp_xor1(float v) { return __builtin_bit_cast(float, __builtin_amdgcn_update_dpp(0, __builtin_bit_cast(int, v), 0xB1, 0xF, 0xF, true)); }
__device__ __forceinline__ float dpp_xor2(float v) { return __builtin_bit_cast(float, __builtin_amdgcn_update_dpp(0, __builtin_bit_cast(int, v), 0x4E, 0xF, 0xF, true)); }
__device__ __forceinline__ float dpp_hmirror(float v) { return __builtin_bit_cast(float, __builtin_amdgcn_update_dpp(0, __builtin_bit_cast(int, v), 0x141, 0xF, 0xF, true)); }
__device__ __forceinline__ float dpp_rmirror(float v) { return __builtin_bit_cast(float, __builtin_amdgcn_update_dpp(0, __builtin_bit_cast(int, v), 0x140, 0xF, 0xF, true)); }
__device__ __forceinline__ f32x4 mfma16(bf16x8 a, bf16x8 b, f32x4 c) { return __builtin_amdgcn_mfma_f32_16x16x32_bf16(a, b, c, 0, 0, 0); }

struct KArgs {
    const float* in[27];
    float* out;
    unsigned char* ws;
    int ph_lo, ph_hi;
};
struct Ctx { unsigned char* ws; float* out; const KArgs* ka; int bx, G, wid; };
__device__ __forceinline__ const float* inp(const Ctx& c, int k) { return c.ka->in[k]; }
__device__ __forceinline__ int opaque_lane() { int z; asm volatile("v_mov_b32 %0, 0" : "=v"(z)); return __builtin_amdgcn_mbcnt_hi(-1, __builtin_amdgcn_mbcnt_lo(-1, z)); }
__device__ __forceinline__ int opaque_tid(int wid) { return wid * 64 + opaque_lane(); }

namespace pg8 {
constexpr int BM = 256, BK = 64, HALF = 128, HTB = HALF * BK * 2, STAGE_BYTES = 8 * HTB, NXCD = 8, WGM = 8;
__host__ __device__ __forceinline__ int lds_byte(int r, int c) { const int st = (r >> 4) * 2 + (c >> 5), rr = r & 15, cc = c & 31, ob = rr * 64 + cc * 2; return st * 1024 + (ob ^ (((ob >> 9) & 1) << 5)); }
__host__ __device__ __forceinline__ void stage_rc(int b, int& R, int& C) { const int st = b / 1024, sb = b % 1024, swz = sb ^ (((sb >> 9) & 1) << 5); R = (st >> 1) * 16 + swz / 64; C = (st & 1) * 32 + (swz % 64) / 2; }
__host__ __device__ __forceinline__ int perm32(int rho) { const int n = rho >> 4, i = rho & 15; return 8 * (i >> 2) + 4 * n + (i & 3); }

struct Unit { int pm, pn; };
struct Gemm { const bf16_t* A; const bf16_t* Bt; int M, N, K, lda, ldb; };

struct StaticOrder {
    int nM, nN, nwg, G, c;
    __device__ void init(int M, int N, int G_, int c_) { nM = M / BM; nN = N / BM; nwg = nM * nN; G = G_; c = c_; }
    __device__ bool next(int i, Unit& u) const {
        const long L = (long)i * G + c; if (L >= nwg) return false;
        int wgid = (int)L; { const int q = nwg / NXCD, r = nwg % NXCD, xcd = wgid % NXCD, off = wgid / NXCD; wgid = (xcd < r ? xcd * (q + 1) : r * (q + 1) + (xcd - r) * q) + off; }
        const int nig = WGM * nN, gid = wgid / nig, fm = gid * WGM, gsz = (nM - fm) < WGM ? (nM - fm) : WGM;
        u.pm = fm + ((wgid % nig) % gsz); u.pn = (wgid % nig) / gsz; return true;
    }
};

template <class Epi>
__device__ __forceinline__ void gemm_phase(LAS unsigned char* lds, const Gemm g, const StaticOrder& S, const Epi& E, const int wid) {
    const int lane = opaque_lane(), tid = wid * 64 + lane, wr = wid >> 2, wc = wid & 3, fr = lane & 15, fq = lane >> 4;
    const int K = g.K, nt = K / BK;
    unsigned voffA[2], voffB[2];
#pragma unroll
    for (int i = 0; i < 2; ++i) { int R, C; stage_rc(tid * 16 + i * 8192, R, C); const int Rb = Epi::PERM ? ((R & ~31) + perm32(R & 31)) : R;
        voffA[i] = (unsigned)(R * g.lda + C) * 2u; voffB[i] = (unsigned)(Rb * g.ldb + C) * 2u; }
    const __amdgpu_buffer_rsrc_t rA = __builtin_amdgcn_make_buffer_rsrc((void*)g.A, 0, -1, 0x00020000);
    const __amdgpu_buffer_rsrc_t rB = __builtin_amdgcn_make_buffer_rsrc((void*)g.Bt, 0, -1, 0x00020000);
    const unsigned kstep = (unsigned)(BK * 2);
    const unsigned hsA = (unsigned)HALF * g.lda * 2u, hsB = (unsigned)HALF * g.ldb * 2u;
    const unsigned tsA = 2u * hsA, tsB = 2u * hsB;
    const unsigned ldsw = (unsigned)wid * 1024u;
    const int aoff = lds_byte(wr * 64 + fr, fq * 8), boff = lds_byte(wc * 32 + fr, fq * 8);
#define PG8_SA(b, h) (((b) * 2 + (h)) * HTB)
#define PG8_SB(b, h) ((4 + (b) * 2 + (h)) * HTB)
#define PG8_STAGE(bufoff, rsrc, soff, voff) do { _Pragma("unroll") for (int _i = 0; _i < 2; ++_i) \
        __builtin_amdgcn_raw_ptr_buffer_load_lds(rsrc, (LAS void*)(lds + (bufoff) + ldsw + _i * 8192), 16, (int)(voff)[_i], (int)(soff), 0, 0); } while (0)
#define PG8_LDA(dst, b, h) do { _Pragma("unroll") for (int m = 0; m < 4; ++m) _Pragma("unroll") for (int k = 0; k < 2; ++k) dst[m][k] = *(const LAS bf16x8*)(lds + PG8_SA(b, h) + aoff + m * 2048 + k * 1024); } while (0)
#define PG8_LDB(dst, b, h) do { _Pragma("unroll") for (int n = 0; n < 2; ++n) _Pragma("unroll") for (int k = 0; k < 2; ++k) dst[n][k] = *(const LAS bf16x8*)(lds + PG8_SB(b, h) + boff + n * 2048 + k * 1024); } while (0)
#define PG8_MMA(ai, bj, At, Bt) do { __builtin_amdgcn_s_setprio(1); _Pragma("unroll") for (int m = 0; m < 4; ++m) _Pragma("unroll") for (int n = 0; n < 2; ++n) _Pragma("unroll") for (int k = 0; k < 2; ++k) \
        acc[ai][bj][m][n] = __builtin_amdgcn_mfma_f32_16x16x32_bf16(Bt[n][k], At[m][k], acc[ai][bj][m][n], 0, 0, 0); __builtin_amdgcn_s_setprio(0); } while (0)
#define PG8_WAIT_V(n) asm volatile("s_waitcnt vmcnt(" #n ")" ::: "memory")
#define PG8_WAIT_L(n) asm volatile("s_waitcnt lgkmcnt(" #n ")" ::: "memory")
#define PG8_BAR __builtin_amdgcn_s_barrier()
#define PG8_SCHED __builtin_amdgcn_sched_barrier(0)
    Unit cur, nxt; int ui = 0;
    if (!S.next(0, cur)) return;
    f32x4 acc[2][2][4][2];
#pragma unroll
    for (int a = 0; a < 2; ++a)
#pragma unroll
        for (int b = 0; b < 2; ++b)
#pragma unroll
            for (int m = 0; m < 4; ++m)
#pragma unroll
                for (int n = 0; n < 2; ++n) acc[a][b][m][n] = (f32x4){0.f, 0.f, 0.f, 0.f};
    bf16x8 At[4][2], B0[2][2], B1[2][2];
    unsigned cA = (unsigned)cur.pm * tsA, cB = (unsigned)cur.pn * tsB;
    PG8_STAGE(PG8_SB(0, 0), rB, cB, voffB); PG8_STAGE(PG8_SB(0, 1), rB, cB + hsB, voffB); PG8_STAGE(PG8_SA(0, 0), rA, cA, voffA); PG8_STAGE(PG8_SA(0, 1), rA, cA + hsA, voffA);
    if (wr == 1) PG8_BAR;
    PG8_WAIT_V(2); PG8_BAR;
    PG8_STAGE(PG8_SB(1, 0), rB, cB + kstep, voffB); PG8_STAGE(PG8_SA(1, 0), rA, cA + kstep, voffA); PG8_STAGE(PG8_SB(1, 1), rB, cB + hsB + kstep, voffB);
    PG8_WAIT_V(6); PG8_BAR;
    for (;;) {
        const bool has_next = S.next(ui + 1, nxt);
        const unsigned nA = has_next ? (unsigned)nxt.pm * tsA : cA, nB = has_next ? (unsigned)nxt.pn * tsB : cB;
        for (int t = 0; t < nt; t += 2) {
            const bool last = (t == nt - 2);
            const unsigned a1 = cA + (unsigned)(t + 1) * kstep;
            const unsigned a2 = last ? nA : cA + (unsigned)(t + 2) * kstep, b2 = last ? nB : cB + (unsigned)(t + 2) * kstep;
            const unsigned a3 = a2 + kstep, b3 = b2 + kstep;
            PG8_LDB(B0, 0, 0); PG8_LDB(B1, 0, 1); PG8_SCHED; PG8_LDA(At, 0, 0); PG8_STAGE(PG8_SA(1, 1), rA, a1 + hsA, voffA);
            PG8_WAIT_V(8); PG8_WAIT_L(0); PG8_BAR; PG8_MMA(0, 0, At, B0); PG8_MMA(0, 1, At, B1); PG8_BAR; PG8_SCHED;
            PG8_LDA(At, 0, 1); PG8_STAGE(PG8_SB(0, 0), rB, b2, voffB); PG8_STAGE(PG8_SB(0, 1), rB, b2 + hsB, voffB); PG8_STAGE(PG8_SA(0, 0), rA, a2, voffA);
            PG8_WAIT_V(8); PG8_WAIT_L(0); PG8_BAR; PG8_MMA(1, 0, At, B0); PG8_MMA(1, 1, At, B1); PG8_BAR; PG8_SCHED;
            PG8_LDB(B0, 1, 0); PG8_LDB(B1, 1, 1); PG8_SCHED; PG8_LDA(At, 1, 0); PG8_STAGE(PG8_SA(0, 1), rA, a2 + hsA, voffA);
            PG8_WAIT_V(8); PG8_WAIT_L(0); PG8_BAR; PG8_MMA(0, 0, At, B0); PG8_MMA(0, 1, At, B1); PG8_BAR; PG8_SCHED;
            PG8_LDA(At, 1, 1); PG8_STAGE(PG8_SB(1, 0), rB, b3, voffB); PG8_STAGE(PG8_SB(1, 1), rB, b3 + hsB, voffB); PG8_STAGE(PG8_SA(1, 0), rA, a3, voffA);
            PG8_WAIT_V(8); PG8_WAIT_L(0); PG8_BAR; PG8_MMA(1, 0, At, B0); PG8_MMA(1, 1, At, B1); PG8_BAR; PG8_SCHED;
        }
        if (wr == 0) PG8_BAR;
        E(acc, cur, wr, wc, fr, fq);
        if (!has_next) break;
#pragma unroll
        for (int a = 0; a < 2; ++a)
#pragma unroll
            for (int b = 0; b < 2; ++b)
#pragma unroll
                for (int m = 0; m < 4; ++m)
#pragma unroll
                    for (int n = 0; n < 2; ++n) acc[a][b][m][n] = (f32x4){0.f, 0.f, 0.f, 0.f};
        cur = nxt; cA = nA; cB = nB; ++ui;
        if (wr == 1) PG8_BAR;
    }
    PG8_WAIT_V(0);
    PG8_BAR;
#undef PG8_SA
#undef PG8_SB
#undef PG8_STAGE
#undef PG8_LDA
#undef PG8_LDB
#undef PG8_MMA
#undef PG8_WAIT_V
#undef PG8_WAIT_L
#undef PG8_BAR
#undef PG8_SCHED
}

template <bool FUSE>
struct EpiInProj {
    static constexpr bool PERM = true;
    unsigned char* ws; int l;
    __device__ __forceinline__ void operator()(const f32x4 (&acc)[2][2][4][2], const Unit& u, int wr, int wc, int fr, int fq) const {
        asm volatile("" : "+v"(fr), "+v"(fq));
        bf16_t* proj = (bf16_t*)(ws + WS_PROJ); float* ssq = (float*)(ws + WS_SSQ); float* G = (float*)(ws + WS_G); float* BETA = (float*)(ws + WS_BETA); bf16_t* KB = (bf16_t*)(ws + WS_KB);
        const float* cosT = (const float*)(ws + WS_COS); const float* sinT = (const float*)(ws + WS_SIN); const float* a_log = (const float*)(ws + WS_SMALL) + l * 4; const float* dt_bias = a_log + 8;
        const int row0 = u.pm * BM + wr * 64 + fr, colb = u.pn * BM + wc * 32 + 8 * fq;
        float rs[2][4]; f32x4 sw[2][2];
        if (FUSE) { f32x4 pp[2][4]; const float* ssqh = (const float*)(ws + WS_SSQH);
#pragma unroll
            for (int ai = 0; ai < 2; ++ai)
#pragma unroll
                for (int m = 0; m < 4; ++m) pp[ai][m] = *(const f32x4*)(ssqh + (size_t)(row0 + ai * HALF + m * 16) * 16 + 4 * fq);
            const float* shw = (const float*)(ws + WS_SHW) + (size_t)(16 + ((u.pm * BM) >> 11)) * 4096 + colb;
#pragma unroll
            for (int bj = 0; bj < 2; ++bj) { sw[bj][0] = *(const f32x4*)(shw + bj * HALF); sw[bj][1] = *(const f32x4*)(shw + bj * HALF + 4); }
#pragma unroll
            for (int ai = 0; ai < 2; ++ai)
#pragma unroll
                for (int m = 0; m < 4; ++m) { float sacc = (pp[ai][m][0] + pp[ai][m][1]) + (pp[ai][m][2] + pp[ai][m][3]); sacc += shx(sacc, 16, fr + 16 * fq); sacc += shx(sacc, 32, fr + 16 * fq);
                    rs[ai][m] = rsqrtf(sacc * (1.0f / ND) + EPS); } }
#pragma unroll
        for (int ai = 0; ai < 2; ++ai)
#pragma unroll
            for (int m = 0; m < 4; ++m) {
                const int r = row0 + ai * HALF + m * 16;
                bf16_t* rowp = proj + (size_t)r * NDINP + colb;
                f32x4 t[2][2];
#pragma unroll
                for (int bj = 0; bj < 2; ++bj) { t[bj][0] = acc[ai][bj][m][0]; t[bj][1] = acc[ai][bj][m][1]; }
                if (FUSE) {
                    const float rstd = rs[ai][m];
#pragma unroll
                    for (int bj = 0; bj < 2; ++bj) { t[bj][0] = t[bj][0] * rstd + sw[bj][0]; t[bj][1] = t[bj][1] * rstd + sw[bj][1]; } }
#pragma unroll
                for (int bj = 0; bj < 2; ++bj) { const f32x4 v0 = t[bj][0], v1 = t[bj][1];
                    u32x4 w; w.x = cvt_pk_bf16(v0[0], v0[1]); w.y = cvt_pk_bf16(v0[2], v0[3]); w.z = cvt_pk_bf16(v1[0], v1[1]); w.w = cvt_pk_bf16(v1[2], v1[3]);
                    *(u32x4*)(rowp + bj * HALF) = w; }
                if (u.pn == 8) {
                    float s = 0.f;
#pragma unroll
                    for (int bj = 0; bj < 2; ++bj)
#pragma unroll
                        for (int n = 0; n < 2; ++n) { const f32x4 x = t[bj][n]; s += (x[0] * x[0] + x[1] * x[1]) + (x[2] * x[2] + x[3] * x[3]); }
                    s += shx(s, 16, fr + 16 * fq); s += shx(s, 32, fr + 16 * fq);
                    if (fq == 0) ssq[8 * r + wc] = s;
                }
                if (u.pn == 9) {
                    float s = 0.f;
#pragma unroll
                    for (int n = 0; n < 2; ++n) { const f32x4 x = t[0][n]; s += (x[0] * x[0] + x[1] * x[1]) + (x[2] * x[2] + x[3] * x[3]); }
                    s += shx(s, 16, fr + 16 * fq); s += shx(s, 32, fr + 16 * fq);
                    if (fq == 0) ssq[8 * r + 4 + wc] = s;
                    if (wc == 0) {
                        const f32x4 x1 = t[1][0], x2 = t[1][1];
                        const f32x4 c = *(const f32x4*)(cosT + (size_t)r * 16 + 4 * fq), sn = *(const f32x4*)(sinT + (size_t)r * 16 + 4 * fq);
                        const f32x4 o1 = x1 * c - x2 * sn, o2 = x2 * c + x1 * sn;
                        u32x4 w; w.x = cvt_pk_bf16(o1[0], o1[1]); w.y = cvt_pk_bf16(o1[2], o1[3]); w.z = cvt_pk_bf16(o2[0], o2[1]); w.w = cvt_pk_bf16(o2[2], o2[3]);
                        const int b = r >> 11, sq = r & 2047;
#pragma unroll
                        for (int h = 0; h < 4; ++h) *(u32x4*)(KB + ((size_t)(b * 4 + h) * NS + sq) * 96 + 64 + 8 * fq) = w;
                    }
                    if (wc == 1 && fq == 0) {
                        const f32x4 av = t[1][0], bv = t[1][1];
                        f32x4 gg, bb;
#pragma unroll
                        for (int h = 0; h < 4; ++h) { gg[h] = -__expf(a_log[h]) * softplusf_(av[h] + dt_bias[h]); bb[h] = sigmoidf_(bv[h]); }
                        *(f32x4*)(G + (size_t)r * 4) = gg; *(f32x4*)(BETA + (size_t)r * 4) = bb;
                    }
                }
                asm volatile("" ::: "memory");
            }
    }
};

struct EpiMLA {
    static constexpr bool PERM = true;
    unsigned char* ws;
    __device__ __forceinline__ void operator()(const f32x4 (&acc)[2][2][4][2], const Unit& u, int wr, int wc, int fr, int fq) const {
        asm volatile("" : "+v"(fr), "+v"(fq));
        bf16_t* QB = (bf16_t*)(ws + WS_QB); bf16_t* KB = (bf16_t*)(ws + WS_KB); bf16_t* VT = (bf16_t*)(ws + WS_VT); const float* ssq = (const float*)(ws + WS_SSQ);
        const float* cosT = (const float*)(ws + WS_COS); const float* sinT = (const float*)(ws + WS_SIN);
        const int row0 = u.pm * BM + wr * 64 + fr;
        const float QSCALE = 0.10206207261596577f * 1.4426950408889634f;
        f32x2 pp[2][4]; float rq8[2][4], rkv8[2][4];
#pragma unroll
        for (int ai = 0; ai < 2; ++ai)
#pragma unroll
            for (int m = 0; m < 4; ++m) pp[ai][m] = *(const f32x2*)(ssq + 8 * (size_t)(row0 + ai * HALF + m * 16) + 2 * fq);
#pragma unroll
        for (int ai = 0; ai < 2; ++ai)
#pragma unroll
            for (int m = 0; m < 4; ++m) { float mine = pp[ai][m].x + pp[ai][m].y; mine += shx(mine, 16, fr + 16 * fq); const float other = shx(mine, 32, fr + 16 * fq);
                const float sq_ = (fq < 2) ? mine : other, sk_ = (fq < 2) ? other : mine;
                rq8[ai][m] = rsqrtf(sq_ * (1.0f / 256.0f) + EPS); rkv8[ai][m] = rsqrtf(sk_ * (1.0f / 128.0f) + EPS); }
#pragma unroll
        for (int ai = 0; ai < 2; ++ai)
#pragma unroll
            for (int m = 0; m < 4; ++m) {
                const int r = row0 + ai * HALF + m * 16;
                const int b = r >> 11, sq = r & 2047;
                const float rq = rq8[ai][m], rkv = rkv8[ai][m];
                if (u.pn != 1) {
                    const float sc = (u.pn == 0) ? rq * QSCALE : rkv;
                    bf16_t* base = (u.pn == 0) ? QB : ((u.pn == 2) ? KB : VT);
                    const int rl = (u.pn == 3) ? 64 : 96;
#pragma unroll
                    for (int bj = 0; bj < 2; ++bj) { const int cq = 128 * bj + 32 * wc + 8 * fq, head = cq >> 6, d = cq & 63;
                        const f32x4 v0 = acc[ai][bj][m][0] * sc, v1 = acc[ai][bj][m][1] * sc;
                        u32x4 w; w.x = cvt_pk_bf16(v0[0], v0[1]); w.y = cvt_pk_bf16(v0[2], v0[3]); w.z = cvt_pk_bf16(v1[0], v1[1]); w.w = cvt_pk_bf16(v1[2], v1[3]);
                        *(u32x4*)(base + ((size_t)(b * 4 + head) * NS + sq) * rl + d) = w; }
                } else {
                    const f32x4 x1 = acc[ai][0][m][0] * rq, x2 = acc[ai][0][m][1] * rq;
                    const f32x4 c = *(const f32x4*)(cosT + (size_t)r * 16 + 4 * fq), sn = *(const f32x4*)(sinT + (size_t)r * 16 + 4 * fq);
                    const f32x4 o1 = (x1 * c - x2 * sn) * QSCALE, o2 = (x2 * c + x1 * sn) * QSCALE;
                    u32x4 w; w.x = cvt_pk_bf16(o1[0], o1[1]); w.y = cvt_pk_bf16(o1[2], o1[3]); w.z = cvt_pk_bf16(o2[0], o2[1]); w.w = cvt_pk_bf16(o2[2], o2[3]);
                    *(u32x4*)(QB + ((size_t)(b * 4 + wc) * NS + sq) * 96 + 64 + 8 * fq) = w;
                }
                asm volatile("" ::: "memory");
            }
    }
};

template <bool FUSE>
struct EpiResid {
    static constexpr bool PERM = false;
    const float* base; float* out; const float* gate; const float* gain; const float* scp; bf16_t* hs; float* ssqh;
    __device__ __forceinline__ void operator()(const f32x4 (&acc)[2][2][4][2], const Unit& u, int wr, int wc, int fr, int fq) const {
        asm volatile("" : "+v"(fr), "+v"(fq));
        const int row0 = u.pm * BM + wr * 64 + fr, col0 = u.pn * BM + wc * 32 + 4 * fq;
        const int b = (u.pm * BM) >> 11;
        f32x4 gv[2][2], gs[2][2];
#pragma unroll
        for (int bj = 0; bj < 2; ++bj)
#pragma unroll
            for (int n = 0; n < 2; ++n) { gv[bj][n] = *(const f32x4*)(gate + (size_t)b * 6144 + col0 + bj * HALF + n * 16);
                if (FUSE) gs[bj][n] = *(const f32x4*)(gain + col0 + bj * HALF + n * 16) * (*(const f32x4*)(scp + (size_t)b * 6144 + col0 + bj * HALF + n * 16) + 1.0f); }
        f32x4 cur[2][2], nxt[2][2];
#pragma unroll
        for (int bj = 0; bj < 2; ++bj)
#pragma unroll
            for (int n = 0; n < 2; ++n) cur[bj][n] = *(const f32x4*)(base + (size_t)row0 * ND + col0 + bj * HALF + n * 16);
#pragma unroll
        for (int it = 0; it < 8; ++it) { const int ai = it >> 2, m = it & 3;
            const int r = row0 + ai * HALF + m * 16; const size_t off = (size_t)r * ND + col0; float ssum = 0.f;
            if (it < 7) { const size_t offn = (size_t)(row0 + ((it + 1) >> 2) * HALF + ((it + 1) & 3) * 16) * ND + col0;
#pragma unroll
                for (int bj = 0; bj < 2; ++bj)
#pragma unroll
                    for (int n = 0; n < 2; ++n) nxt[bj][n] = *(const f32x4*)(base + offn + bj * HALF + n * 16); }
#pragma unroll
            for (int bj = 0; bj < 2; ++bj)
#pragma unroll
                for (int n = 0; n < 2; ++n) {
                    const f32x4 o = cur[bj][n] + gv[bj][n] * acc[ai][bj][m][n];
                    *(f32x4*)(out + off + bj * HALF + n * 16) = o;
                    if (FUSE) { ssum += (o[0] * o[0] + o[1] * o[1]) + (o[2] * o[2] + o[3] * o[3]); const f32x4 hv = o * gs[bj][n];
                        u32x2 w; w.x = cvt_pk_bf16(hv[0], hv[1]); w.y = cvt_pk_bf16(hv[2], hv[3]); *(u32x2*)(hs + off + bj * HALF + n * 16) = w; } }
            if (FUSE) { ssum += shx(ssum, 16, fr + 16 * fq); ssum += shx(ssum, 32, fr + 16 * fq); if (fq == 0) ssqh[(size_t)r * 16 + u.pn * 4 + wc] = ssum; }
            asm volatile("" ::: "memory");
#pragma unroll
            for (int bj = 0; bj < 2; ++bj)
#pragma unroll
                for (int n = 0; n < 2; ++n) cur[bj][n] = nxt[bj][n]; }
    }
};

template <bool FUSE>
struct EpiRelu2 {
    static constexpr bool PERM = true;
    bf16_t* O; int ldc; const float* ssqh; const float* shw;
    __device__ __forceinline__ void operator()(const f32x4 (&acc)[2][2][4][2], const Unit& u, int wr, int wc, int fr, int fq) const {
        asm volatile("" : "+v"(fr), "+v"(fq));
        const int row0 = u.pm * BM + wr * 64 + fr, col0 = u.pn * BM + wc * 32 + 8 * fq;
        const int b = (u.pm * BM) >> 11;
        f32x4 sw[2][2];
        if (FUSE) {
#pragma unroll
            for (int bj = 0; bj < 2; ++bj) { sw[bj][0] = *(const f32x4*)(shw + (size_t)b * 4096 + col0 + bj * HALF); sw[bj][1] = *(const f32x4*)(shw + (size_t)b * 4096 + col0 + bj * HALF + 4); } }
        float rs[2][4];
        if (FUSE) { f32x4 pp[2][4];
#pragma unroll
            for (int ai = 0; ai < 2; ++ai)
#pragma unroll
                for (int m = 0; m < 4; ++m) pp[ai][m] = *(const f32x4*)(ssqh + (size_t)(row0 + ai * HALF + m * 16) * 16 + 4 * fq);
#pragma unroll
            for (int ai = 0; ai < 2; ++ai)
#pragma unroll
                for (int m = 0; m < 4; ++m) { float sacc = (pp[ai][m][0] + pp[ai][m][1]) + (pp[ai][m][2] + pp[ai][m][3]); sacc += shx(sacc, 16, fr + 16 * fq); sacc += shx(sacc, 32, fr + 16 * fq);
                    rs[ai][m] = rsqrtf(sacc * (1.0f / ND) + EPS); } }
#pragma unroll
        for (int ai = 0; ai < 2; ++ai)
#pragma unroll
            for (int m = 0; m < 4; ++m) { const int r = row0 + ai * HALF + m * 16; bf16_t* rowp = O + (size_t)r * ldc + col0;
                const float rstd = FUSE ? rs[ai][m] : 1.0f;
#pragma unroll
                for (int bj = 0; bj < 2; ++bj) { f32x4 v0 = acc[ai][bj][m][0], v1 = acc[ai][bj][m][1];
                    if (FUSE) { v0 = v0 * rstd + sw[bj][0]; v1 = v1 * rstd + sw[bj][1]; }
#pragma unroll
                    for (int j = 0; j < 4; ++j) { const float a = fmaxf(v0[j], 0.f), c = fmaxf(v1[j], 0.f); v0[j] = a * a; v1[j] = c * c; }
                    u32x4 w; w.x = cvt_pk_bf16(v0[0], v0[1]); w.y = cvt_pk_bf16(v0[2], v0[3]); w.z = cvt_pk_bf16(v1[0], v1[1]); w.w = cvt_pk_bf16(v1[2], v1[3]);
                    __builtin_nontemporal_store(w, (u32x4*)(rowp + bj * HALF)); } }
    }
};
}

__device__ __forceinline__ float wval(const Ctx& a, int mat, int l, int k, int n) {
    if (mat == 0) {
        int src;
        if (n < 1024) src = n;
        else if (n < 2432) src = n + 8;
        else if (n < 2464) { const int p = n - 2432, g = p >> 3, w = p & 7; src = 2440 + ((w < 4) ? 4 * g + w : 16 + 4 * g + (w - 4)); }
        else if (n < 2472) src = 1024 + (n - 2464);
        else return 0.f;
        return inp(a, 6)[((size_t)l * 1024 + k) * NDIN + src];
    } else if (mat == 1) {
        if (n < 384) {
            if (k >= 256) return 0.f;
            int col;
            if (n < 256) col = (n >> 6) * 96 + (n & 63);
            else { const int p = n - 256, head = p >> 5, pp = p & 31, g = pp >> 3, w = pp & 7; col = head * 96 + 64 + ((w < 4) ? 4 * g + w : 16 + 4 * g + (w - 4)); }
            return inp(a, 19)[((size_t)l * 256 + k) * 384 + col] * inp(a, 18)[l * 256 + k];
        } else if (n < 512) return 0.f;
        else {
            if (k < 256) return 0.f;
            const int kk = k - 256, mm = (n - 512) & 255, head = mm >> 6, d = mm & 63;
            const int col = head * 128 + ((n >= 768) ? 64 : 0) + d;
            return inp(a, 21)[((size_t)l * 128 + kk) * 512 + col] * inp(a, 20)[l * 128 + kk];
        }
    } else if (mat == 2) return inp(a, 22)[((size_t)l * 1024 + k) * 1024 + n];
    else if (mat == 3) return inp(a, 24)[((size_t)l * 1024 + k) * 4096 + n];
    else return inp(a, 25)[((size_t)l * 4096 + k) * 1024 + n];
}

__device__ __forceinline__ void transpose_item(const Ctx& a, int mat, int l, int K, int N, bf16_t* WT, LAS float* scr, int item, int lane) {
    const int nblk = N / 32, kb = item / nblk, nb = item % nblk, k0 = 64 * kb, n0 = 32 * nb;
    float wv[32];
#pragma unroll
    for (int i = 0; i < 32; ++i) wv[i] = wval(a, mat, l, k0 + 2 * i + (lane >> 5), n0 + (lane & 31));
#pragma unroll
    for (int i = 0; i < 32; ++i) scr[(2 * i + (lane >> 5)) * 33 + (lane & 31)] = wv[i];
    asm volatile("s_waitcnt lgkmcnt(0)" ::: "memory");
    const int c = lane & 7;
#pragma unroll
    for (int j = 0; j < 4; ++j) { const int n = (lane >> 3) + 8 * j; const LAS float* s = scr + (8 * c) * 33 + n;
        u32x4 o; o.x = cvt_pk_bf16(s[0 * 33], s[1 * 33]); o.y = cvt_pk_bf16(s[2 * 33], s[3 * 33]); o.z = cvt_pk_bf16(s[4 * 33], s[5 * 33]); o.w = cvt_pk_bf16(s[6 * 33], s[7 * 33]);
        *(u32x4*)(WT + (size_t)(n0 + n) * K + k0 + 8 * c) = o; }
    asm volatile("s_waitcnt lgkmcnt(0)" ::: "memory");
}

__device__ __forceinline__ void prologue_phase(const Ctx& a, LAS unsigned char* lds) {
    const int tid = opaque_tid(a.wid), lane = tid & 63, wave = tid >> 6;
    const int G = a.G, bx = a.bx, gw = bx * NWAVES + wave, NGW = G * NWAVES;
    unsigned char* ws = a.ws;
    if (bx == 0) { unsigned* ctl = (unsigned*)(ws + WS_CTL); for (int i = tid; i < 1024; i += NTHREADS) ctl[i] = 0u;
        if (tid < 8) { float* sm = (float*)(ws + WS_SMALL); sm[tid] = inp(a, 8)[tid]; sm[8 + tid] = inp(a, 9)[tid]; } }
    {
        LAS float* scr = (LAS float*)(lds + wave * 8704);
        constexpr int I0 = 16 * 80, I1 = 6 * 32, I2 = 16 * 32, I3 = 16 * 128, I4 = 64 * 32, IL = I0 + I1 + I2 + I3 + I4;
        for (int it = gw; it < 2 * IL; it += NGW) {
            const int l = it / IL; int r = it % IL;
            if (r < I0) { transpose_item(a, 0, l, 1024, NDINP, (bf16_t*)(ws + WS_WIN) + (size_t)l * NDINP * 1024, scr, r, lane); continue; } r -= I0;
            if (r < I1) { transpose_item(a, 1, l, 384, 1024, (bf16_t*)(ws + WS_WMLA) + (size_t)l * 1024 * 384, scr, r, lane); continue; } r -= I1;
            if (r < I2) { transpose_item(a, 2, l, 1024, 1024, (bf16_t*)(ws + WS_WOUT) + (size_t)l * 1024 * 1024, scr, r, lane); continue; } r -= I2;
            if (r < I3) { transpose_item(a, 3, l, 1024, 4096, (bf16_t*)(ws + WS_W1) + (size_t)l * 4096 * 1024, scr, r, lane); continue; } r -= I3;
            transpose_item(a, 4, l, 4096, 1024, (bf16_t*)(ws + WS_W2) + (size_t)l * 1024 * 4096, scr, r, lane);
        }
    }
    {
        float* cosT = (float*)(ws + WS_COS); float* sinT = (float*)(ws + WS_SIN);
        const int* pos = (const int*)inp(a, 2);
        for (int idx = bx * NTHREADS + tid; idx < NT * 16; idx += G * NTHREADS) {
            const int tok = idx >> 4, i = idx & 15;
            const float inv = powf(10000.0f, -(float)(2 * i) / 32.0f);
            const float ang = (float)pos[tok] * inv;
            float s, c; sincosf(ang, &s, &c);
            cosT[idx] = c; sinT[idx] = s;
        }
    }
    __syncthreads();
    if (bx < 192) {
        LAS float* cact = (LAS float*)lds;
        LAS float* red = (LAS float*)(lds + 65536);
        for (int i = tid; i < 16 * 1024; i += NTHREADS) cact[i] = siluf_(inp(a, 1)[i]);
        __syncthreads();
        const int l = bx / 96, n0 = (bx % 96) * 64, col = tid & 63, kg = tid >> 6;
        float acc[16];
#pragma unroll
        for (int b = 0; b < 16; ++b) acc[b] = 0.f;
        const float* wp = inp(a, 3) + ((size_t)l * 1024 + kg * 128) * 6144 + n0 + col;
        for (int k4 = 0; k4 < 128; k4 += 4) {
            const float w0 = wp[(size_t)(k4 + 0) * 6144], w1 = wp[(size_t)(k4 + 1) * 6144], w2 = wp[(size_t)(k4 + 2) * 6144], w3 = wp[(size_t)(k4 + 3) * 6144];
#pragma unroll
            for (int b = 0; b < 16; ++b) { const f32x4 cv = *(const LAS f32x4*)(cact + b * 1024 + kg * 128 + k4); acc[b] += cv[0] * w0 + cv[1] * w1 + cv[2] * w2 + cv[3] * w3; }
        }
#pragma unroll
        for (int b = 0; b < 16; ++b) red[(kg * 16 + b) * 64 + col] = acc[b];
        __syncthreads();
        float* MOD = (float*)(ws + WS_MOD);
        for (int o = tid; o < 1024; o += NTHREADS) { const int b = o >> 6, cc = o & 63; float s = inp(a, 4)[l * 6144 + n0 + cc];
#pragma unroll
            for (int g2 = 0; g2 < 8; ++g2) s += red[(g2 * 16 + b) * 64 + cc];
            MOD[((size_t)l * 16 + b) * 6144 + n0 + cc] = s; }
    }
    __syncthreads();
}

__device__ __forceinline__ void norm_phase(const Ctx& a, const float* src, const float* gain, const float* modl, int sh_off, int sc_off, bool zero_ssq) {
    const int tid = opaque_tid(a.wid), lane = tid & 63, wave = tid >> 6;
    const int gw = a.bx * NWAVES + wave, NGW = a.G * NWAVES;
    bf16_t* U = (bf16_t*)(a.ws + WS_U);
    for (int row = gw; row < NT; row += NGW) {
        const int b = row >> 11;
        const f32x4* xr = (const f32x4*)(src + (size_t)row * ND) + lane;
        f32x4 v[4]; float s = 0.f;
#pragma unroll
        for (int j = 0; j < 4; ++j) { v[j] = xr[64 * j]; s += (v[j][0] * v[j][0] + v[j][1] * v[j][1]) + (v[j][2] * v[j][2] + v[j][3] * v[j][3]); }
        const float rstd = rsqrtf(wave_sum(s, lane) * (1.0f / ND) + EPS);
        u32x2* o8 = (u32x2*)(U + (size_t)row * ND) + lane;
#pragma unroll
        for (int j = 0; j < 4; ++j) { const int c = 4 * lane + 256 * j;
            const f32x4 g = *(const f32x4*)(gain + c), sc = *(const f32x4*)(modl + (size_t)b * 6144 + sc_off + c), sh = *(const f32x4*)(modl + (size_t)b * 6144 + sh_off + c);
            const f32x4 y = v[j] * rstd * g * (sc + 1.0f) + sh;
            u32x2 w; w.x = cvt_pk_bf16(y[0], y[1]); w.y = cvt_pk_bf16(y[2], y[3]); o8[64 * j] = w; }
    }
}

__device__ __forceinline__ void shw_item(const Ctx& a, LAS unsigned char* lds, const int item) {
    const int tid = opaque_tid(a.wid), lane = tid & 63, w = tid >> 6, fr = lane & 15, fq = lane >> 4;
    const int idx = (item < 32) ? 0 : ((item < 52) ? 1 : 2), n0 = ((item < 32) ? item : ((item < 52) ? item - 32 : item - 52)) * 128;
    const int l = (idx == 0) ? 0 : 1, shoff = (idx == 1) ? 0 : 3072;
    const float* MOD = (const float*)(a.ws + WS_MOD);
    const bf16_t* WT = (idx == 1) ? (const bf16_t*)(a.ws + WS_WIN) + (size_t)NDINP * 1024 : (const bf16_t*)(a.ws + WS_W1) + (size_t)l * 4096 * 1024;
    LAS bf16_t* shb = (LAS bf16_t*)lds;
    __syncthreads();
    for (int i = tid; i < 16 * 1024; i += NTHREADS) shb[(i >> 10) * 1032 + (i & 1023)] = f2bf(MOD[((size_t)l * 16 + (i >> 10)) * 6144 + shoff + (i & 1023)]);
    __syncthreads();
    const bf16_t* wrow = WT + (size_t)(n0 + 16 * w + fr) * 1024 + 8 * fq;
    f32x4 d = {0.f, 0.f, 0.f, 0.f};
#pragma unroll 8
    for (int ks = 0; ks < 32; ++ks) {
        const bf16x8 af = *(const LAS bf16x8*)(shb + fr * 1032 + 32 * ks + 8 * fq);
        const bf16x8 bf_ = *(const bf16x8*)(wrow + 32 * ks);
        d = mfma16(af, bf_, d);
    }
    float* SHW = (float*)(a.ws + WS_SHW);
#pragma unroll
    for (int r = 0; r < 4; ++r) SHW[((size_t)idx * 16 + 4 * fq + r) * 4096 + n0 + 16 * w + fr] = d[r];
}

__device__ __forceinline__ void final_norm_phase(const Ctx& a) {
    const int tid = opaque_tid(a.wid), lane = tid & 63, wave = tid >> 6;
    const int gw = a.bx * NWAVES + wave, NGW = a.G * NWAVES;
    const float* gain = inp(a, 26);
    for (int row = gw; row < NT; row += NGW) {
        f32x4* xr = (f32x4*)(a.out + (size_t)row * ND) + lane;
        f32x4 v[4]; float s = 0.f;
#pragma unroll
        for (int j = 0; j < 4; ++j) { v[j] = xr[64 * j]; s += (v[j][0] * v[j][0] + v[j][1] * v[j][1]) + (v[j][2] * v[j][2] + v[j][3] * v[j][3]); }
        const float rstd = rsqrtf(wave_sum(s, lane) * (1.0f / ND) + EPS);
#pragma unroll
        for (int j = 0; j < 4; ++j) { const f32x4 g = *(const f32x4*)(gain + 4 * lane + 256 * j); __builtin_nontemporal_store(v[j] * rstd * g, xr + 64 * j); }
    }
}

#define XB_TMO      128
#define XB_XCNT(j)  (256  + 64 * (j))
#define XB_XSUB(j)  (1280 + 64 * (j))
#define XB_XGEN(j)  (2304 + 64 * (j))
#define XB_TOP      3328
#define XB_TOPGEN   3392
#define XCD_BAR_WORDS 3456
#define XB_SPIN_CAP (1u << 22)
__device__ __forceinline__ unsigned xb_ld(unsigned* p)              { return __hip_atomic_load(p, __ATOMIC_RELAXED, __HIP_MEMORY_SCOPE_AGENT); }
__device__ __forceinline__ unsigned xb_add(unsigned* p, unsigned v) { return __hip_atomic_fetch_add(p, v, __ATOMIC_RELAXED, __HIP_MEMORY_SCOPE_AGENT); }
__device__ __forceinline__ unsigned xb_xcc_id() { return (unsigned)__builtin_amdgcn_s_getreg((3 << 11) | 20) & 0xFu; }
#define XB_SPIN(cond, bar) do { unsigned _sp = 0; while (cond) { __builtin_amdgcn_s_sleep(1); \
    if ((++_sp & 255u) == 0u) { if (xb_ld(&(bar)[XB_TMO])) break; if (_sp > XB_SPIN_CAP) { atomicAdd(&(bar)[XB_TMO], 1u); break; } } } } while (0)
__device__ __forceinline__ void xcd_barrier_complete(unsigned* bar, unsigned x, unsigned G, unsigned& nloc, unsigned& nx) {
    unsigned sum, cnt, mine, sp = 0u;
    for (;;) {
        sum = 0u; cnt = 0u; mine = 0u;
#pragma unroll
        for (unsigned j = 0; j < 16; ++j) { const unsigned c = xb_ld(&bar[XB_XCNT(j)]); sum += c; cnt += (c > 0u) ? 1u : 0u; mine = (j == x) ? c : mine; }
        if (sum == G) break;
        __builtin_amdgcn_s_sleep(1);
        if ((++sp & 255u) == 0u) { if (xb_ld(&bar[XB_TMO])) break; if (sp > XB_SPIN_CAP) { atomicAdd(&bar[XB_TMO], 1u); break; } }
    }
    nloc = mine > 0u ? mine : 1u; nx = cnt > 0u ? cnt : 1u;
}
__device__ __forceinline__ void grid_bar(unsigned* bar, int G, int wid, volatile LAS unsigned* st) {
    asm volatile("s_waitcnt vmcnt(0)" ::: "memory");
    __syncthreads();
    if (opaque_tid(wid) == 0) {
        __builtin_amdgcn_s_waitcnt(0);
        const unsigned x = xb_xcc_id();
        unsigned nloc = st[0], nx = st[1];
        if (nloc == 0u) { xcd_barrier_complete(bar, x, (unsigned)G, nloc, nx); st[0] = nloc; st[1] = nx; }
        const unsigned old = xb_add(&bar[XB_XSUB(x)], 1u);
        const unsigned gen = old / nloc;
        if (old + 1u == (gen + 1u) * nloc) {
            __builtin_amdgcn_fence(__ATOMIC_RELEASE, "agent");
            asm volatile("s_waitcnt vmcnt(0)" ::: "memory");
            const unsigned og = xb_add(&bar[XB_TOP], 1u);
            const unsigned tg = og / nx;
            if (og + 1u == (tg + 1u) * nx) xb_add(&bar[XB_TOPGEN], 1u);
            else XB_SPIN(xb_ld(&bar[XB_TOPGEN]) == tg, bar);
            __builtin_amdgcn_fence(__ATOMIC_ACQUIRE, "agent");
            xb_add(&bar[XB_XGEN(x)], 1u);
            asm volatile("s_waitcnt vmcnt(0)" ::: "memory");
        } else {
            XB_SPIN(xb_ld(&bar[XB_XGEN(x)]) == gen, bar);
            __builtin_amdgcn_fence(__ATOMIC_ACQUIRE, "agent");
            asm volatile("s_waitcnt vmcnt(0)" ::: "memory");
        }
    }
    __syncthreads();
}

__device__ __forceinline__ int q_pop(unsigned* ctr, LAS unsigned* slot, int wid) {
    __syncthreads();
    if (opaque_tid(wid) == 0) *slot = atomicAdd(ctr, 1u);
    __syncthreads();
    return (int)*slot;
}

__device__ __forceinline__ void conv8(const bf16_t* p, int rstride, int s, const float* w, int wstride, float (&o)[8]) {
#pragma unroll
    for (int e = 0; e < 8; ++e) o[e] = 0.f;
#pragma unroll
    for (int j = 0; j < 4; ++j) {
        const int d = 3 - j;
        if (s - d >= 0) {
            const u32x4 v = *(const u32x4*)(p - (size_t)d * rstride);
            const f32x4 w0 = *(const f32x4*)(w + j * wstride), w1 = *(const f32x4*)(w + j * wstride + 4);
            o[0] += w0[0] * bflo(v.x); o[1] += w0[1] * bfhi(v.x); o[2] += w0[2] * bflo(v.y); o[3] += w0[3] * bfhi(v.y);
            o[4] += w1[0] * bflo(v.z); o[5] += w1[1] * bfhi(v.z); o[6] += w1[2] * bflo(v.w); o[7] += w1[3] * bfhi(v.w);
        }
    }
}

__device__ __forceinline__ void conv8r(const u32x4 (&rows)[4], const float* w, int wstride, float (&o)[8]) {
#pragma unroll
    for (int e = 0; e < 8; ++e) o[e] = 0.f;
#pragma unroll
    for (int j = 0; j < 4; ++j) {
        const u32x4 v = rows[j];
        const f32x4 w0 = *(const f32x4*)(w + j * wstride), w1 = *(const f32x4*)(w + j * wstride + 4);
        o[0] += w0[0] * bflo(v.x); o[1] += w0[1] * bfhi(v.x); o[2] += w0[2] * bflo(v.y); o[3] += w0[3] * bfhi(v.y);
        o[4] += w1[0] * bflo(v.z); o[5] += w1[1] * bfhi(v.z); o[6] += w1[2] * bflo(v.w); o[7] += w1[3] * bfhi(v.w);
    }
}
__device__ __forceinline__ void conv8r_lds(const u32x4 (&rows)[4], const LAS float* w, int wstride, float (&o)[8]) {
#pragma unroll
    for (int e = 0; e < 8; ++e) o[e] = 0.f;
#pragma unroll
    for (int j = 0; j < 4; ++j) {
        const u32x4 v = rows[j];
        const f32x4 w0 = *(const LAS f32x4*)(w + j * wstride), w1 = *(const LAS f32x4*)(w + j * wstride + 4);
        o[0] += w0[0] * bflo(v.x); o[1] += w0[1] * bfhi(v.x); o[2] += w0[2] * bflo(v.y); o[3] += w0[3] * bfhi(v.y);
        o[4] += w1[0] * bflo(v.z); o[5] += w1[1] * bfhi(v.z); o[6] += w1[2] * bflo(v.w); o[7] += w1[3] * bfhi(v.w);
    }
}
__device__ __forceinline__ void gdn_prep_load(const Ctx& a, int it, int tid, u32x4 (&rq)[4], u32x4 (&rk)[4], u32x4 (&rv)[4], float& gl_, float& bl_) {
    const int bh = it >> 5, n = it & 31, b = bh >> 2, h = bh & 3, tok = tid >> 3, cg_ = tid & 7, s = 64 * n + tok;
    const bf16_t* p = (const bf16_t*)(a.ws + WS_PROJ) + (size_t)(b * NS + s) * NDINP + h * 64 + 8 * cg_;
#pragma unroll
    for (int j = 0; j < 4; ++j) { const int d = 3 - j;
        if (s - d >= 0) { const bf16_t* r = p - (size_t)d * NDINP; rq[j] = *(const u32x4*)r; rk[j] = *(const u32x4*)(r + 256); rv[j] = *(const u32x4*)(r + 512); }
        else { rq[j] = (u32x4){0u, 0u, 0u, 0u}; rk[j] = rq[j]; rv[j] = rq[j]; } }
    const size_t gi = ((size_t)(b * NS + 64 * n + (tid & 63))) * 4 + h;
    gl_ = ((const float*)(a.ws + WS_G))[gi]; bl_ = ((const float*)(a.ws + WS_BETA))[gi];
}

__device__ __forceinline__ void rglru_item(const Ctx& a, int l, int item, LAS unsigned char* lds) {
    const int tid = opaque_tid(a.wid), lane = tid & 63, w = tid >> 6, fr = lane & 15, fq = lane >> 4;
    const int b = item >> 3, g = item & 7;
    const bf16_t* PROJ = (const bf16_t*)(a.ws + WS_PROJ);
    bf16_t* MIX = (bf16_t*)(a.ws + WS_U);
    LAS bf16_t* XCb = (LAS bf16_t*)lds;
    LAS bf16_t* WaT = (LAS bf16_t*)(lds + 18432);
    LAS bf16_t* WxT = (LAS bf16_t*)(lds + 18432 + 9216);
    LAS float* SEG = (LAS float*)(lds + 36864);
    for (int idx = tid; idx < 4096; idx += NTHREADS) { const int i = idx >> 6, j = idx & 63;
        WaT[j * 72 + i] = f2bf(inp(a, 13)[(((size_t)l * 8 + g) * 64 + i) * 64 + j]);
        WxT[j * 72 + i] = f2bf(inp(a, 15)[(((size_t)l * 8 + g) * 64 + i) * 64 + j]); }
    float ba[4], bx[4], sp8[4], hc[4];
#pragma unroll
    for (int cb = 0; cb < 4; ++cb) { const int ch = l * 512 + g * 64 + 16 * cb + fr; ba[cb] = inp(a, 14)[ch]; bx[cb] = inp(a, 16)[ch]; sp8[cb] = -8.0f * softplusf_(-inp(a, 17)[ch]); hc[cb] = 0.f; }
    const int cg_ = tid & 7;
    const float* cw = inp(a, 11) + (size_t)l * 4 * 512 + g * 64 + 8 * cg_;
    float cbias[8];
#pragma unroll
    for (int e = 0; e < 8; ++e) cbias[e] = inp(a, 12)[l * 512 + g * 64 + 8 * cg_ + e];
    u32x4 crow[2][4], nrow[2][4];
#define RG_LOADROWS(dst, scx) do { _Pragma("unroll") for (int jj = 0; jj < 2; ++jj) { const int s_ = 128 * (scx) + (tid >> 3) + 64 * jj; \
        const bf16_t* p_ = PROJ + ((size_t)(b * NS + s_)) * NDINP + 1024 + g * 64 + 8 * cg_; \
        _Pragma("unroll") for (int j = 0; j < 4; ++j) { const int d_ = 3 - j; dst[jj][j] = (s_ - d_ >= 0) ? *(const u32x4*)(p_ - (size_t)d_ * NDINP) : (u32x4){0u, 0u, 0u, 0u}; } } } while (0)
    RG_LOADROWS(crow, 0);
    for (int sc = 0; sc < 16; ++sc) {
        __syncthreads();
#pragma unroll
        for (int jj = 0; jj < 2; ++jj) {
            const int tok = (tid >> 3) + 64 * jj;
            float o[8]; conv8r(crow[jj], cw, 512, o);
            u32x4 wv; wv.x = cvt_pk_bf16(o[0] + cbias[0], o[1] + cbias[1]); wv.y = cvt_pk_bf16(o[2] + cbias[2], o[3] + cbias[3]);
            wv.z = cvt_pk_bf16(o[4] + cbias[4], o[5] + cbias[5]); wv.w = cvt_pk_bf16(o[6] + cbias[6], o[7] + cbias[7]);
            *(LAS u32x4*)(XCb + tok * 72 + 8 * cg_) = wv;
        }
        __syncthreads();
        { const int scn = (sc + 1 < 16) ? sc + 1 : sc; RG_LOADROWS(nrow, scn); }
        unsigned short gate16[4][4];
        { const size_t tokb = (size_t)(b * NS + 128 * sc + 16 * w + 4 * fq);
#pragma unroll
          for (int cb = 0; cb < 4; ++cb)
#pragma unroll
            for (int r = 0; r < 4; ++r) gate16[cb][r] = PROJ[(tokb + r) * NDINP + 1536 + g * 64 + 16 * cb + fr]; }
        bf16x8 af[2];
#pragma unroll
        for (int ks = 0; ks < 2; ++ks) af[ks] = *(const LAS bf16x8*)(XCb + (16 * w + fr) * 72 + 32 * ks + 8 * fq);
        float cum[4][4], hl[4][4];
#pragma unroll
        for (int cb = 0; cb < 4; ++cb) {
            f32x4 da = {0.f, 0.f, 0.f, 0.f}, dx = {0.f, 0.f, 0.f, 0.f};
#pragma unroll
            for (int ks = 0; ks < 2; ++ks) {
                const bf16x8 wa = *(const LAS bf16x8*)(WaT + (16 * cb + fr) * 72 + 32 * ks + 8 * fq);
                const bf16x8 wx = *(const LAS bf16x8*)(WxT + (16 * cb + fr) * 72 + 32 * ks + 8 * fq);
                da = mfma16(af[ks], wa, da); dx = mfma16(af[ks], wx, dx);
            }
            float pa = 1.f, ph = 0.f;
#pragma unroll
            for (int r = 0; r < 4; ++r) {
                const float xc = bf2f(XCb[(16 * w + 4 * fq + r) * 72 + 16 * cb + fr]);
                const float rr = sigmoidf_(da[r] + ba[cb]), ii = sigmoidf_(dx[r] + bx[cb]);
                const float la = sp8[cb] * rr;
                const float av = __expf(la), x2 = 2.0f * la;
                const float em = (x2 > -0.1f) ? -x2 * (1.0f + x2 * (0.5f + x2 * (0.16666667f + x2 * 0.041666668f))) : 1.0f - av * av;
                const float mult = __builtin_amdgcn_sqrtf(em);
                const float bt = mult * ii * xc;
                pa *= av; ph = av * ph + bt;
                cum[cb][r] = pa; hl[cb][r] = ph;
            }
        }
        float pre_a[4], pre_h[4], tot_a[4], tot_h[4];
#pragma unroll
        for (int cb = 0; cb < 4; ++cb) {
            float ea = 1.f, eh = 0.f, ta = 1.f, th = 0.f;
#pragma unroll
            for (int q = 0; q < 4; ++q) {
                const float qa = shl_(cum[cb][3], fr + 16 * q), qh = shl_(hl[cb][3], fr + 16 * q);
                if (q < fq) { eh = qa * eh + qh; ea *= qa; }
                th = qa * th + qh; ta *= qa;
            }
            pre_a[cb] = ea; pre_h[cb] = eh; tot_a[cb] = ta; tot_h[cb] = th;
        }
        LAS float* seg = SEG + (sc & 1) * (8 * 64 * 2);
        if (fq == 0) {
#pragma unroll
            for (int cb = 0; cb < 4; ++cb) *(LAS f32x2*)(seg + (w * 64 + 16 * cb + fr) * 2) = (f32x2){tot_a[cb], tot_h[cb]};
        }
        __syncthreads();
        const int tok0 = b * NS + 128 * sc + 16 * w + 4 * fq;
#pragma unroll
        for (int cb = 0; cb < 4; ++cb) {
            float h_in = hc[cb], h_all = hc[cb];
#pragma unroll
            for (int w2 = 0; w2 < 8; ++w2) { const f32x2 t = *(const LAS f32x2*)(seg + (w2 * 64 + 16 * cb + fr) * 2);
                h_all = t.x * h_all + t.y; if (w2 < w) h_in = h_all; }
            hc[cb] = h_all;
            const float h0 = pre_a[cb] * h_in + pre_h[cb];
#pragma unroll
            for (int r = 0; r < 4; ++r) {
                const float h = hl[cb][r] + cum[cb][r] * h0;
                const size_t tok = (size_t)(tok0 + r);
                const float gt = bf2f(gate16[cb][r]);
                const float y = 0.7978845608028654f * (gt + 0.044715f * gt * gt * gt);
                const float th = 1.0f - 2.0f * __builtin_amdgcn_rcpf(1.0f + __expf(2.0f * y));
                MIX[tok * ND + 256 + g * 64 + 16 * cb + fr] = f2bf(h * 0.5f * gt * (1.0f + th));
            }
        }
#pragma unroll
        for (int jj = 0; jj < 2; ++jj)
#pragma unroll
            for (int j = 0; j < 4; ++j) crow[jj][j] = nrow[jj][j];
    }
#undef RG_LOADROWS
}

__device__ __forceinline__ void gdn_prep_item(const Ctx& a, int l, int it, LAS unsigned char* lds, const u32x4 (&rq)[4], const u32x4 (&rk)[4], const u32x4 (&rv)[4], const float g_lane, const float b_lane) {
    const int tid = opaque_tid(a.wid), lane = tid & 63, w = tid >> 6, fr = lane & 15, fq = lane >> 4;
    const int bh = it >> 5, n = it & 31, b = bh >> 2, h = bh & 3;
    const bf16_t* PROJ = (const bf16_t*)(a.ws + WS_PROJ);
    const float* Gg = (const float*)(a.ws + WS_G); const float* Bg = (const float*)(a.ws + WS_BETA);
    bf16_t* Wg = (bf16_t*)(a.ws + WS_GDN) + (size_t)it * 4096; bf16_t* QDg = Wg + GDN_ARR; bf16_t* QKg = QDg + GDN_ARR; bf16_t* KTTg = QKg + GDN_ARR; bf16_t* UTg = KTTg + GDN_ARR;
    float* CDg = (float*)(a.ws + WS_CD);
    LAS bf16_t* Qs = (LAS bf16_t*)lds;
    LAS bf16_t* Ks = (LAS bf16_t*)(lds + 9216);
    LAS bf16_t* KBs = (LAS bf16_t*)(lds + 18432);
    LAS float* R = (LAS float*)(lds + 27648);
    LAS float* Ls = (LAS float*)(lds + 27648 + 33280);
    LAS float* gcs = (LAS float*)(lds + 27648 + 33280 + 16384);
    LAS float* bts = gcs + 64;
    const int tok = tid >> 3, cg_ = tid & 7, s = 64 * n + tok;
    const size_t trow = (size_t)(b * NS + s);
    float q8[8], k8[8], v8[8];
    {
        const LAS float* cw = (const LAS float*)(lds + 80 * 1024) + h * 768 + 8 * cg_;
        conv8r_lds(rq, cw, 192, q8); conv8r_lds(rk, cw + 64, 192, k8); conv8r_lds(rv, cw + 128, 192, v8);
        float sq = 0.f, sk = 0.f;
#pragma unroll
        for (int e = 0; e < 8; ++e) { q8[e] = siluf_(q8[e]); k8[e] = siluf_(k8[e]); v8[e] = siluf_(v8[e]); sq += q8[e] * q8[e]; sk += k8[e] * k8[e]; }
        sq += dpp_xor1(sq); sq += dpp_xor2(sq); sq += dpp_hmirror(sq);
        sk += dpp_xor1(sk); sk += dpp_xor2(sk); sk += dpp_hmirror(sk);
        const float rq = rsqrtf(sq + EPS) * 0.125f, rk = rsqrtf(sk + EPS);
#pragma unroll
        for (int e = 0; e < 8; ++e) { q8[e] *= rq; k8[e] *= rk; }
    }
    float gv = g_lane;
#pragma unroll
    for (int o = 1; o < 64; o <<= 1) { const float t = shl_(gv, (lane - o) & 63); if (lane >= o) gv += t; }
    __syncthreads();
    if (w == 0) { gcs[lane] = gv; bts[lane] = b_lane; }
    {
        const float gc = shl_(gv, tok & 63), gl = shl_(gv, 63), bt = shl_(b_lane, tok & 63);
        const float eg = __expf(gc), et = __expf(gl - gc);
        u32x4 wq, wk, wkb, wqd;
        wq.x = cvt_pk_bf16(q8[0], q8[1]); wq.y = cvt_pk_bf16(q8[2], q8[3]); wq.z = cvt_pk_bf16(q8[4], q8[5]); wq.w = cvt_pk_bf16(q8[6], q8[7]);
        wk.x = cvt_pk_bf16(k8[0], k8[1]); wk.y = cvt_pk_bf16(k8[2], k8[3]); wk.z = cvt_pk_bf16(k8[4], k8[5]); wk.w = cvt_pk_bf16(k8[6], k8[7]);
        wkb.x = cvt_pk_bf16(k8[0] * bt, k8[1] * bt); wkb.y = cvt_pk_bf16(k8[2] * bt, k8[3] * bt); wkb.z = cvt_pk_bf16(k8[4] * bt, k8[5] * bt); wkb.w = cvt_pk_bf16(k8[6] * bt, k8[7] * bt);
        wqd.x = cvt_pk_bf16(q8[0] * eg, q8[1] * eg); wqd.y = cvt_pk_bf16(q8[2] * eg, q8[3] * eg); wqd.z = cvt_pk_bf16(q8[4] * eg, q8[5] * eg); wqd.w = cvt_pk_bf16(q8[6] * eg, q8[7] * eg);
        *(LAS u32x4*)(Qs + tok * 72 + 8 * cg_) = wq; *(LAS u32x4*)(Ks + tok * 72 + 8 * cg_) = wk; *(LAS u32x4*)(KBs + tok * 72 + 8 * cg_) = wkb;
        *(u32x4*)(QDg + tok * 64 + 8 * cg_) = wqd;
#pragma unroll
        for (int e = 0; e < 8; ++e) { R[tok * 129 + 8 * cg_ + e] = v8[e] * bt; R[tok * 129 + 64 + 8 * cg_ + e] = k8[e] * bt * eg; KTTg[(8 * cg_ + e) * 64 + tok] = f2bf(k8[e] * et); }
        if (tid == 0) CDg[it] = __expf(gl);
    }
    __syncthreads();
    {
        const int mat = w >> 2, rb = w & 3;
        const LAS bf16_t* As = mat ? Qs : KBs;
        bf16x8 bf_[2];
#pragma unroll
        for (int ks = 0; ks < 2; ++ks) bf_[ks] = *(const LAS bf16x8*)(As + (16 * rb + fr) * 72 + 32 * ks + 8 * fq);
        const int i = 16 * rb + fr; const float gci = gcs[i];
#pragma unroll
        for (int cb = 0; cb < 4; ++cb) {
            f32x4 d = {0.f, 0.f, 0.f, 0.f};
            if (cb <= rb) {
#pragma unroll
                for (int ks = 0; ks < 2; ++ks) { const bf16x8 kf = *(const LAS bf16x8*)(Ks + (16 * cb + fr) * 72 + 32 * ks + 8 * fq); d = mfma16(kf, bf_[ks], d); }
#pragma unroll
                for (int r = 0; r < 4; ++r) { const int j = 16 * cb + 4 * fq + r; const bool keep = mat ? (i >= j) : (i > j);
                    d[r] = keep ? d[r] * __expf(gci - gcs[j]) : 0.f; }
            }
            if (mat == 0) { if (cb <= rb) *(LAS f32x4*)(Ls + i * 64 + 16 * cb + 4 * fq) = d; }
            else { u32x2 o; o.x = cvt_pk_bf16(d[0], d[1]); o.y = cvt_pk_bf16(d[2], d[3]); *(u32x2*)(QKg + i * 64 + 16 * cb + 4 * fq) = o; }
        }
    }
    __syncthreads();
    {
        const int c = lane >> 2, p = lane & 3, col = 16 * w + c;
        float xs[4][4];
#pragma unroll
        for (int I = 0; I < 4; ++I) {
            if (I > 0) {
                f32x4 d = {0.f, 0.f, 0.f, 0.f};
#pragma unroll
                for (int J = 0; J < I; ++J)
#pragma unroll
                    for (int s2 = 0; s2 < 4; ++s2) {
                        const float av = Ls[(16 * I + fr) * 64 + 16 * J + 4 * s2 + fq];
                        const float bv = R[(16 * J + 4 * s2 + fq) * 129 + 16 * w + fr];
                        d = __builtin_amdgcn_mfma_f32_16x16x4f32(av, bv, d, 0, 0, 0);
                    }
#pragma unroll
                for (int r = 0; r < 4; ++r) R[(16 * I + 4 * fq + r) * 129 + 16 * w + fr] -= d[r];
            }
#pragma unroll
            for (int jj = 0; jj < 4; ++jj) xs[I][jj] = 0.f;
#pragma unroll
            for (int sb = 0; sb < 4; ++sb) {
                f32x4 Lv[4]; float rhs[4], tot[4];
#pragma unroll
                for (int r = 0; r < 4; ++r) { Lv[r] = *(const LAS f32x4*)(Ls + (16 * I + 4 * sb + r) * 64 + 16 * I + 4 * p); rhs[r] = R[(16 * I + 4 * sb + r) * 129 + col]; }
#pragma unroll
                for (int r = 0; r < 4; ++r) { float part = (p < sb) ? (Lv[r][0] * xs[I][0] + Lv[r][1] * xs[I][1]) + (Lv[r][2] * xs[I][2] + Lv[r][3] * xs[I][3]) : 0.f;
                    part += dpp_xor1(part); part += dpp_xor2(part); tot[r] = rhs[r] - part; }
                const float x0 = tot[0];
                const float x1 = tot[1] - Lv[1][0] * x0;
                const float x2 = tot[2] - (Lv[2][0] * x0 + Lv[2][1] * x1);
                const float x3 = tot[3] - (Lv[3][0] * x0 + Lv[3][1] * x1 + Lv[3][2] * x2);
                if (p == sb) { xs[I][0] = x0; xs[I][1] = x1; xs[I][2] = x2; xs[I][3] = x3;
                    R[(16 * I + 4 * sb + 0) * 129 + col] = x0; R[(16 * I + 4 * sb + 1) * 129 + col] = x1; R[(16 * I + 4 * sb + 2) * 129 + col] = x2; R[(16 * I + 4 * sb + 3) * 129 + col] = x3; }
            }
        }
        if (w < 4) {
#pragma unroll
            for (int m = 0; m < 4; ++m) { u32x2 o; o.x = cvt_pk_bf16(xs[m][0], xs[m][1]); o.y = cvt_pk_bf16(xs[m][2], xs[m][3]); *(u32x2*)(UTg + col * 64 + 16 * m + 4 * p) = o; }
        } else {
#pragma unroll
            for (int m = 0; m < 4; ++m)
#pragma unroll
                for (int j = 0; j < 4; ++j) Wg[(16 * m + 4 * p + j) * 64 + (col - 64)] = f2bf(xs[m][j]);
        }
    }
}

__device__ __forceinline__ void gdn_scan_item(const Ctx& a, int l, int bh, LAS unsigned char* lds) {
    const int tid = opaque_tid(a.wid), lane = tid & 63, w = tid >> 6, fr = lane & 15, fq = lane >> 4;
    const int es = w & 3, ih = w >> 2, b = bh >> 2, h = bh & 3;
    const bf16_t* PROJ = (const bf16_t*)(a.ws + WS_PROJ);
    bf16_t* MIX = (bf16_t*)(a.ws + WS_U);
    const float* CDg = (const float*)(a.ws + WS_CD);
    LAS bf16_t* STs = (LAS bf16_t*)lds;
    LAS bf16_t* VNs = (LAS bf16_t*)(lds + 9216);
    LAS float* SS = (LAS float*)(lds + 18432);
    for (int i = tid; i < 9216 / 4; i += NTHREADS) ((LAS unsigned*)STs)[i] = 0u;
    f32x4 stC[2] = {{0.f, 0.f, 0.f, 0.f}, {0.f, 0.f, 0.f, 0.f}};
    const float ng = inp(a, 10)[l * 64 + 16 * es + fr];
    bf16_t* mixp = MIX + ((size_t)(b * NS + 32 * ih + 4 * fq)) * ND + h * 64 + 16 * es + fr;
    __syncthreads();
    bf16x8 wf[2][2], qdf[2][2], qkf[2][2], ktf[2][2]; u32x2 uv[2]; float cd; unsigned short zz[2][4];
    bf16x8 nwf[2][2], nqdf[2][2], nqkf[2][2], nktf[2][2]; u32x2 nuv[2]; float ncd; unsigned short nzz[2][4];
    bf16x8 mwf[2][2]; u32x2 muv[2];
    unsigned offW[2], offU[2], offZ[2][4];
#pragma unroll
    for (int x = 0; x < 2; ++x) { offW[x] = (unsigned)(((16 * (2 * ih + x) + fr) * 64 + 8 * fq) * 2); offU[x] = (unsigned)(((16 * es + fr) * 64 + 16 * (2 * ih + x) + 4 * fq) * 2);
#pragma unroll
        for (int r = 0; r < 4; ++r) offZ[x][r] = (unsigned)(((16 * (2 * ih + x) + 4 * fq + r) * NDINP + 16 * es + fr) * 2); }
    const char* gdn_base = (const char*)(a.ws + WS_GDN);
    const char* z_base = (const char*)(a.ws + WS_PROJ) + ((size_t)b * NS * NDINP + 768 + h * 64) * 2;
#define SCAN_LOAD(W_, QD_, QK_, KT_, UV_, CD_, ZZ_, itx) do { \
        const char* bW_ = gdn_base + (size_t)(itx) * 8192; const char* bQD_ = bW_ + GDN_ARR * 2; const char* bQK_ = bQD_ + GDN_ARR * 2; const char* bKT_ = bQK_ + GDN_ARR * 2; const char* bU_ = bKT_ + GDN_ARR * 2; \
        const char* bZ_ = z_base + (size_t)(64 * ((itx) & 31)) * NDINP * 2; \
        _Pragma("unroll") for (int x = 0; x < 2; ++x) { \
            _Pragma("unroll") for (int ks = 0; ks < 2; ++ks) { W_[x][ks] = *(const bf16x8*)(bW_ + offW[x] + 64 * ks); QD_[x][ks] = *(const bf16x8*)(bQD_ + offW[x] + 64 * ks); \
                QK_[x][ks] = *(const bf16x8*)(bQK_ + offW[x] + 64 * ks); KT_[x][ks] = *(const bf16x8*)(bKT_ + offW[x] + 64 * ks); } \
            UV_[x] = *(const u32x2*)(bU_ + offU[x]); \
            _Pragma("unroll") for (int r = 0; r < 4; ++r) ZZ_[x][r] = *(const unsigned short*)(bZ_ + offZ[x][r]); } \
        CD_ = CDg[itx]; } while (0)
#define SCAN_LOAD_WU(W_, UV_, itx) do { const char* bW_ = gdn_base + (size_t)(itx) * 8192; const char* bU_ = bW_ + 4 * GDN_ARR * 2; \
        _Pragma("unroll") for (int x = 0; x < 2; ++x) { \
            _Pragma("unroll") for (int ks = 0; ks < 2; ++ks) W_[x][ks] = *(const bf16x8*)(bW_ + offW[x] + 64 * ks); \
            UV_[x] = *(const u32x2*)(bU_ + offU[x]); } } while (0)
    SCAN_LOAD(wf, qdf, qkf, ktf, uv, cd, zz, bh * 32);
    SCAN_LOAD_WU(mwf, muv, bh * 32 + 1);
    for (int n = 0; n < 32; ++n) {
        const int itn = bh * 32 + ((n + 1 < 32) ? n + 1 : n);
        SCAN_LOAD(nwf, nqdf, nqkf, nktf, nuv, ncd, nzz, itn);
#pragma unroll
        for (int x = 0; x < 2; ++x) { nuv[x] = muv[x];
#pragma unroll
            for (int ks = 0; ks < 2; ++ks) nwf[x][ks] = mwf[x][ks]; }
        { const int itm = bh * 32 + ((n + 2 < 32) ? n + 2 : 31); SCAN_LOAD_WU(mwf, muv, itm); }
        __builtin_amdgcn_s_setprio(1);
        bf16x8 stf[2];
#pragma unroll
        for (int ks = 0; ks < 2; ++ks) stf[ks] = *(const LAS bf16x8*)(STs + (16 * es + fr) * 72 + 32 * ks + 8 * fq);
#pragma unroll
        for (int x = 0; x < 2; ++x) {
            f32x4 d = {0.f, 0.f, 0.f, 0.f};
#pragma unroll
            for (int ks = 0; ks < 2; ++ks) d = mfma16(wf[x][ks], stf[ks], d);
            const float v0 = bflo(uv[x].x) - d[0], v1 = bfhi(uv[x].x) - d[1], v2 = bflo(uv[x].y) - d[2], v3 = bfhi(uv[x].y) - d[3];
            u32x2 o; o.x = cvt_pk_bf16(v0, v1); o.y = cvt_pk_bf16(v2, v3);
            *(LAS u32x2*)(VNs + (16 * es + fr) * 72 + 16 * (2 * ih + x) + 4 * fq) = o;
        }
        __syncthreads();
        bf16x8 vnf[2];
#pragma unroll
        for (int ks = 0; ks < 2; ++ks) vnf[ks] = *(const LAS bf16x8*)(VNs + (16 * es + fr) * 72 + 32 * ks + 8 * fq);
        f32x4 o[2];
#pragma unroll
        for (int x = 0; x < 2; ++x) {
            f32x4 d = {0.f, 0.f, 0.f, 0.f};
#pragma unroll
            for (int ks = 0; ks < 2; ++ks) d = mfma16(qdf[x][ks], stf[ks], d);
#pragma unroll
            for (int ks = 0; ks < 2; ++ks) d = mfma16(qkf[x][ks], vnf[ks], d);
            o[x] = d;
#pragma unroll
            for (int r = 0; r < 4; ++r) { float sq = d[r] * d[r];
                sq += dpp_xor1(sq); sq += dpp_xor2(sq); sq += dpp_hmirror(sq); sq += dpp_rmirror(sq);
                if (fr == 0) SS[(16 * (2 * ih + x) + 4 * fq + r) * 4 + es] = sq; }
        }
#pragma unroll
        for (int x = 0; x < 2; ++x) {
            f32x4 d = stC[x] * cd;
#pragma unroll
            for (int ks = 0; ks < 2; ++ks) d = mfma16(vnf[ks], ktf[x][ks], d);
            stC[x] = d;
#pragma unroll
            for (int r = 0; r < 4; ++r) STs[(16 * es + 4 * fq + r) * 72 + 16 * (2 * ih + x) + fr] = f2bf(d[r]);
        }
        __syncthreads();
        __builtin_amdgcn_s_setprio(0);
#pragma unroll
        for (int x = 0; x < 2; ++x)
#pragma unroll
            for (int r = 0; r < 4; ++r) {
                const int i = 16 * (2 * ih + x) + 4 * fq + r;
                const f32x4 ss = *(const LAS f32x4*)(SS + i * 4);
                const float rstd = __builtin_amdgcn_rsqf(((ss[0] + ss[1]) + (ss[2] + ss[3])) * (1.0f / 64.0f) + EPS);
                const float z = bf2f(zz[x][r]);
                mixp[(size_t)(16 * x + r) * ND] = f2bf(o[x][r] * rstd * ng * z * __builtin_amdgcn_rcpf(1.0f + __expf(-z)));
            }
        mixp += (size_t)64 * ND;
#pragma unroll
        for (int x = 0; x < 2; ++x) {
#pragma unroll
            for (int ks = 0; ks < 2; ++ks) { wf[x][ks] = nwf[x][ks]; qdf[x][ks] = nqdf[x][ks]; qkf[x][ks] = nqkf[x][ks]; ktf[x][ks] = nktf[x][ks]; }
            uv[x] = nuv[x];
#pragma unroll
            for (int r = 0; r < 4; ++r) zz[x][r] = nzz[x][r]; }
        cd = ncd;
    }
#undef SCAN_LOAD
#undef SCAN_LOAD_WU
}

__device__ __forceinline__ void attn_unit(const Ctx& a, int bh, int jq4, LAS unsigned char* lds) {
    const int tid = opaque_tid(a.wid), lane = tid & 63, w = tid >> 6, fr = lane & 15, fq = lane >> 4;
    const int b = bh >> 2, h = bh & 3;
    const bf16_t* QB = (const bf16_t*)(a.ws + WS_QB); const bf16_t* KB = (const bf16_t*)(a.ws + WS_KB); const bf16_t* VT = (const bf16_t*)(a.ws + WS_VT);
    bf16_t* MIX = (bf16_t*)(a.ws + WS_U);
    LAS unsigned char* Ks = lds;
    LAS unsigned char* Vs = lds + 13312;
    const int q0 = 256 * jq4;
    bf16x8 qf[2][3];
#pragma unroll
    for (int rb = 0; rb < 2; ++rb) { const bf16_t* qrow = QB + ((size_t)bh * NS + q0 + 32 * w + 16 * rb + fr) * 96 + 8 * fq;
#pragma unroll
      for (int ks = 0; ks < 3; ++ks) qf[rb][ks] = *(const bf16x8*)(qrow + 32 * ks); }
    float m_run[2] = {-INFINITY, -INFINITY}, l_part[2] = {0.f, 0.f};
    f32x4 o[2][4];
#pragma unroll
    for (int rb = 0; rb < 2; ++rb)
#pragma unroll
        for (int db = 0; db < 4; ++db) o[rb][db] = (f32x4){0.f, 0.f, 0.f, 0.f};
    const int ntile = 4 * jq4 + 4, my_nt = 4 * jq4 + 1 + (w >> 1);
    const unsigned char* kbase = (const unsigned char*)(KB + (size_t)bh * NS * 96);
    const bf16_t* vbase = VT + (size_t)bh * NS * 64;
    u32x4 kr0, kr1 = {0u, 0u, 0u, 0u}, vr;
    const int vd = tid >> 3, vc = tid & 7;
    kr0 = *(const u32x4*)(kbase + (size_t)tid * 16);
    if (tid < 256) kr1 = *(const u32x4*)(kbase + (size_t)(512 + tid) * 16);
    vr = *(const u32x4*)(vbase + (size_t)vd * 64 + 8 * vc);
    for (int tile = 0; tile < ntile; ++tile) {
        __syncthreads();
        { const int ch = tid; *(LAS u32x4*)(Ks + (ch / 12) * 208 + (ch % 12) * 16) = kr0; }
        if (tid < 256) { const int ch = 512 + tid; *(LAS u32x4*)(Ks + (ch / 12) * 208 + (ch % 12) * 16) = kr1; }
        *(LAS u32x4*)(Vs + vd * 160 + vc * 16) = vr;
        __syncthreads();
        if (tile + 1 < ntile) {
            const unsigned char* kt = kbase + (size_t)(tile + 1) * 64 * 192;
            kr0 = *(const u32x4*)(kt + (size_t)tid * 16);
            if (tid < 256) kr1 = *(const u32x4*)(kt + (size_t)(512 + tid) * 16);
            vr = *(const u32x4*)(vbase + (size_t)(64 * (tile + 1) + vd) * 64 + 8 * vc);
        }
        if (tile < my_nt) {
            f32x4 s[2][4];
#pragma unroll
            for (int kb = 0; kb < 4; ++kb) {
                f32x4 d0 = {0.f, 0.f, 0.f, 0.f}, d1 = {0.f, 0.f, 0.f, 0.f};
#pragma unroll
                for (int ks = 0; ks < 3; ++ks) { const bf16x8 kf = *(const LAS bf16x8*)(Ks + (16 * kb + fr) * 208 + 64 * ks + 16 * fq); d0 = mfma16(kf, qf[0][ks], d0); d1 = mfma16(kf, qf[1][ks], d1); }
                s[0][kb] = d0; s[1][kb] = d1;
            }
            bf16x8 pf[2][2];
#pragma unroll
            for (int rb = 0; rb < 2; ++rb) {
                float mx = fmaxf(fmaxf(fmaxf(s[rb][0][0], s[rb][0][1]), fmaxf(s[rb][0][2], s[rb][0][3])), fmaxf(fmaxf(s[rb][1][0], s[rb][1][1]), fmaxf(s[rb][1][2], s[rb][1][3])));
                mx = fmaxf(mx, fmaxf(fmaxf(fmaxf(s[rb][2][0], s[rb][2][1]), fmaxf(s[rb][2][2], s[rb][2][3])), fmaxf(fmaxf(s[rb][3][0], s[rb][3][1]), fmaxf(s[rb][3][2], s[rb][3][3]))));
                mx = fmaxf(mx, shx(mx, 16, lane)); mx = fmaxf(mx, shx(mx, 32, lane));
                if (__builtin_amdgcn_ballot_w64(mx > m_run[rb] + 8.0f) != 0ull) {
                    const float m_new = fmaxf(m_run[rb], mx);
                    const float al = __builtin_amdgcn_exp2f(m_run[rb] - m_new);
                    m_run[rb] = m_new; l_part[rb] *= al;
#pragma unroll
                    for (int db = 0; db < 4; ++db) o[rb][db] = o[rb][db] * al;
                }
                const float m_use = m_run[rb];
                float ps = 0.f;
#pragma unroll
                for (int kb = 0; kb < 4; ++kb)
#pragma unroll
                    for (int r = 0; r < 4; ++r) { s[rb][kb][r] = __builtin_amdgcn_exp2f(s[rb][kb][r] - m_use); ps += s[rb][kb][r]; }
                l_part[rb] += ps;
#pragma unroll
                for (int ks = 0; ks < 2; ++ks) {
                    u32x4 t; t.x = cvt_pk_bf16(s[rb][2 * ks][0], s[rb][2 * ks][1]); t.y = cvt_pk_bf16(s[rb][2 * ks][2], s[rb][2 * ks][3]);
                    t.z = cvt_pk_bf16(s[rb][2 * ks + 1][0], s[rb][2 * ks + 1][1]); t.w = cvt_pk_bf16(s[rb][2 * ks + 1][2], s[rb][2 * ks + 1][3]);
                    pf[rb][ks] = __builtin_bit_cast(bf16x8, t);
                }
            }
#pragma unroll
            for (int db = 0; db < 4; ++db) {
                f32x4 d0 = o[0][db], d1 = o[1][db];
#pragma unroll
                for (int ks = 0; ks < 2; ++ks) {
                    const LAS unsigned char* vp = Vs + (32 * ks + 4 * fq + (fr >> 2)) * 160 + (16 * db + 4 * (fr & 3)) * 2;
                    const s16x4 lo = __builtin_amdgcn_ds_read_tr16_b64_v4i16((LAS s16x4*)vp);
                    const s16x4 hi = __builtin_amdgcn_ds_read_tr16_b64_v4i16((LAS s16x4*)(vp + 16 * 160));
                    const bf16x8 va = __builtin_shufflevector(lo, hi, 0, 1, 2, 3, 4, 5, 6, 7);
                    d0 = mfma16(va, pf[0][ks], d0); d1 = mfma16(va, pf[1][ks], d1);
                }
                o[0][db] = d0; o[1][db] = d1;
            }
        }
    }
#pragma unroll
    for (int rb = 0; rb < 2; ++rb) {
        float lsum = l_part[rb]; lsum += shx(lsum, 16, lane); lsum += shx(lsum, 32, lane);
        const float inv = 1.0f / lsum;
        bf16_t* op = MIX + ((size_t)(b * NS + q0 + 32 * w + 16 * rb + fr)) * ND + 768 + h * 64 + 4 * fq;
#pragma unroll
        for (int db = 0; db < 4; ++db) { u32x2 t; t.x = cvt_pk_bf16(o[rb][db][0] * inv, o[rb][db][1] * inv); t.y = cvt_pk_bf16(o[rb][db][2] * inv, o[rb][db][3] * inv); *(u32x2*)(op + 16 * db) = t; }
    }
}

constexpr int N_PHASES = 18;
#ifndef PMASK
#define PMASK 0xFFFF
#endif
#define PM(k) (((PMASK) >> (k)) & 1)
#ifndef REPMASK
#define REPMASK 0
#endif
template <int PH, int REP>
__device__ __forceinline__ void phase_body(const KArgs& ka, LAS unsigned char* lds, const int wid0) {
    LAS unsigned* qslot = (LAS unsigned*)(lds + 140 * 1024);
    Ctx a; a.ws = ka.ws; a.out = ka.out; a.ka = &ka;
    a.bx = blockIdx.x; a.G = gridDim.x; a.wid = wid0;
    asm volatile("" : "+s"(a.bx), "+s"(a.G), "+s"(a.wid));
    const int G = a.G;
    unsigned char* ws = a.ws;
    float* MOD = (float*)(ws + WS_MOD);
    unsigned* ctl = (unsigned*)(ws + WS_CTL);
    constexpr int l = (PH - 1) >> 3, sub = (PH == 0) ? 8 : ((PH == N_PHASES - 1) ? 9 : ((PH - 1) & 7));
    const float* modl = MOD + (size_t)l * 16 * 6144;
    constexpr bool skipped = (sub == 5) || (sub == 0 && l == 1);
    if constexpr (skipped) return;
    if constexpr (sub == 8) { if (PM(0)) prologue_phase(a, lds); }
    else if constexpr (sub == 9) { if (PM(1)) final_norm_phase(a); }
    else if constexpr (sub == 0) { if (PM(2)) { norm_phase(a, inp(a, 0), inp(a, 5), modl, 0, 1024, true); } }
    else if constexpr (sub == 1) { if (PM(3)) {
        pg8::Gemm g{(const bf16_t*)(ws + (l == 0 ? WS_U : WS_HS)), (const bf16_t*)(ws + WS_WIN) + (size_t)l * NDINP * 1024, NT, NDINP, 1024, 1024, 1024};
        pg8::StaticOrder S; S.init(NT, NDINP, G, a.bx);
        pg8::EpiInProj<(l == 1)> E{ws, l};
        pg8::gemm_phase<pg8::EpiInProj<(l == 1)>>(lds, g, S, E, a.wid); } }
    else if constexpr (sub == 2) {
        if (PM(4)) {
        pg8::Gemm g{(const bf16_t*)(ws + WS_PROJ) + 2048, (const bf16_t*)(ws + WS_WMLA) + (size_t)l * 1024 * 384, NT, 1024, 384, NDINP, 384};
        pg8::StaticOrder S; S.init(NT, 1024, G, a.bx);
        pg8::EpiMLA E{ws};
        pg8::gemm_phase<pg8::EpiMLA>(lds, g, S, E, a.wid); }
        if (PM(6)) {
            const int ptid = opaque_tid(a.wid);
            { LAS float* cwl = (LAS float*)(lds + 80 * 1024);
              for (int idx = ptid; idx < 3072; idx += NTHREADS) { const int hh = idx / 768, rem = idx % 768, j = rem / 192, part = (rem % 192) >> 6, ch = rem & 63;
                  cwl[idx] = inp(a, 7)[((size_t)l * 4 + j) * 768 + part * 256 + hh * 64 + ch]; }
              __syncthreads(); }
            u32x4 rq[4], rk[4], rv[4]; float gl_ = 0.f, bl_ = 0.f;
            int it = a.bx;
            if (it < 2048) gdn_prep_load(a, it, ptid, rq, rk, rv, gl_, bl_);
            for (; it < 2048; it += a.G) {
                u32x4 nq[4], nk[4], nv[4]; float ngl, nbl;
                const int itn = (it + a.G < 2048) ? it + a.G : it;
                gdn_prep_load(a, itn, ptid, nq, nk, nv, ngl, nbl);
                gdn_prep_item(a, l, it, lds, rq, rk, rv, gl_, bl_);
#pragma unroll
                for (int j = 0; j < 4; ++j) { rq[j] = nq[j]; rk[j] = nk[j]; rv[j] = nv[j]; }
                gl_ = ngl; bl_ = nbl;
            }
        }
    } else if constexpr (sub == 3) {
        if (PM(7)) { if (a.bx < 64) gdn_scan_item(a, l, a.bx, lds); }
        unsigned* ctr = ctl + 64 * (2 * l + 1 + 4 * REP);
        constexpr int NQ = 128 + 512 + (l == 0 ? 84 : 0);
        for (;;) { const int u = q_pop(ctr, qslot, a.wid); if (u >= NQ) break;
            if (u < 128) { if (PM(5)) rglru_item(a, l, u, lds); } else if (u < 640) { if (PM(8)) attn_unit(a, (u - 128) & 63, 7 - ((u - 128) >> 6), lds); } else shw_item(a, lds, u - 640); }
    } else if constexpr (sub == 4) { if (PM(9)) {
        pg8::Gemm g{(const bf16_t*)(ws + WS_U), (const bf16_t*)(ws + WS_WOUT) + (size_t)l * 1024 * 1024, NT, 1024, 1024, 1024, 1024};
        pg8::StaticOrder S; S.init(NT, 1024, G, a.bx);
        pg8::EpiResid<true> E{(l == 0) ? inp(a, 0) : a.out, a.out, modl + 2048, inp(a, 23) + l * ND, modl + 4096, (bf16_t*)(ws + WS_HS), (float*)(ws + WS_SSQH)};
        pg8::gemm_phase<pg8::EpiResid<true>>(lds, g, S, E, a.wid); } }
    else if constexpr (sub == 7) { if (PM(9)) {
        pg8::Gemm g{(const bf16_t*)(ws + WS_HID), (const bf16_t*)(ws + WS_W2) + (size_t)l * 1024 * 4096, NT, 1024, NFF, NFF, NFF};
        pg8::StaticOrder S; S.init(NT, 1024, G, a.bx);
        pg8::EpiResid<(l == 0)> E{a.out, a.out, modl + 5120, inp(a, 5) + ND, MOD + (size_t)16 * 6144 + 1024, (bf16_t*)(ws + WS_HS), (float*)(ws + WS_SSQH)};
        pg8::gemm_phase<pg8::EpiResid<(l == 0)>>(lds, g, S, E, a.wid); } }
    else { if (PM(10)) {
        pg8::Gemm g{(const bf16_t*)(ws + WS_HS), (const bf16_t*)(ws + WS_W1) + (size_t)l * 4096 * 1024, NT, NFF, 1024, 1024, 1024};
        pg8::StaticOrder S; S.init(NT, NFF, G, a.bx);
        pg8::EpiRelu2<true> E{(bf16_t*)(ws + WS_HID), NFF, (const float*)(ws + WS_SSQH), (const float*)(ws + WS_SHW) + (size_t)(l == 0 ? 0 : 2) * 16 * 4096};
        pg8::gemm_phase<pg8::EpiRelu2<true>>(lds, g, S, E, a.wid); } }
    if (REP == 0 ? (((REPMASK) >> sub) & 1) || (PH + 1 < ka.ph_hi) : (PH + 1 < ka.ph_hi)) grid_bar((unsigned*)(ws + WS_BAR), a.G, a.wid, (volatile LAS unsigned*)(lds + 142 * 1024));
}
template <int PH>
__device__ __forceinline__ void run_phase(const KArgs& ka, LAS unsigned char* lds, const int wid0) {
    constexpr int sub = (PH == 0) ? 8 : ((PH == N_PHASES - 1) ? 9 : ((PH - 1) & 7));
    phase_body<PH, 0>(ka, lds, wid0);
    if constexpr (((REPMASK) >> sub) & 1) phase_body<PH, 1>(ka, lds, wid0);
}

__global__ void __launch_bounds__(NTHREADS, 2) mk_fwd(KArgs ka) {
    extern __shared__ __attribute__((aligned(16))) unsigned char lds_raw[];
    LAS unsigned char* lds = (LAS unsigned char*)lds_raw;
    cg::grid_group grid = cg::this_grid();
    if (ka.ph_lo < -7) grid.sync();
    const int wid0 = __builtin_amdgcn_readfirstlane((int)(threadIdx.x >> 6));
    if (threadIdx.x == 0) { ((volatile LAS unsigned*)(lds + 142 * 1024))[0] = 0u; ((volatile LAS unsigned*)(lds + 142 * 1024))[1] = 0u;
        (void)xb_add(&((unsigned*)(ka.ws + WS_BAR))[XB_XCNT(xb_xcc_id())], 1u); }
    __syncthreads();
#define RUNP(k) if (ka.ph_lo <= (k) && (k) < ka.ph_hi) run_phase<k>(ka, lds, wid0);
    RUNP(0) RUNP(1) RUNP(2) RUNP(3) RUNP(4) RUNP(5) RUNP(6) RUNP(7) RUNP(8) RUNP(9) RUNP(10) RUNP(11) RUNP(12) RUNP(13) RUNP(14) RUNP(15) RUNP(16) RUNP(17)
#undef RUNP
}

#ifdef DBG_STOP
__global__ void dbg_hash(const unsigned char* ws, float* out) {
    __shared__ unsigned hs;
    const int item = blockIdx.x; if (threadIdx.x == 0) hs = 0u; __syncthreads();
    unsigned h = 0u;
    const bf16_t* Gd = (const bf16_t*)(ws + WS_GDN);
    for (int k = threadIdx.x; k < 5 * 4096; k += blockDim.x) { const unsigned v = Gd[(size_t)(k >> 12) * GDN_ARR + (size_t)item * 4096 + (k & 4095)]; h += (v + 1u) * ((unsigned)k * 2654435761u + 12345u); }
    if (threadIdx.x == 0) h += __float_as_uint(((const float*)(ws + WS_CD))[item]) * 7919u;
    atomicAdd(&hs, h); __syncthreads();
    const float f = (float)(hs >> 8) * (1.0f / 65536.0f);
    for (int k = threadIdx.x; k < 16384; k += blockDim.x) out[(size_t)item * 16384 + k] = f;
}
__global__ void dbg_dump(const unsigned char* ws, float* out, int which) {
    const size_t i = (size_t)blockIdx.x * blockDim.x + threadIdx.x; if (i >= (size_t)NT * ND) return;
    const size_t t = i >> 10, c = i & 1023; float v = 0.f;
    if (which == 1) v = bf2f(((const bf16_t*)(ws + WS_U))[i]);
    else if (which == 2) { const bf16_t* P = (const bf16_t*)(ws + WS_PROJ) + t * NDINP; v = bf2f(P[c]) + 2.f * bf2f(P[c + 1024]) + 3.f * bf2f(P[2048 + (c & 511)]);
        v += ((const float*)(ws + WS_G))[t * 4 + (c & 3)] + ((const float*)(ws + WS_BETA))[t * 4 + (c & 3)] + 1e-3f * ((const float*)(ws + WS_SSQ))[t * 8 + (c & 7)]; }
    else if (which == 3) { v = bf2f(((const bf16_t*)(ws + WS_QB))[(t * 4 + (c >> 8)) * 96 + (c & 255) % 96]) + bf2f(((const bf16_t*)(ws + WS_KB))[(t * 4 + (c >> 8)) * 96 + (c & 255) % 96]) + bf2f(((const bf16_t*)(ws + WS_VT))[t * 256 + (c & 255)]); }
    else if (which == 4) { const bf16_t* Gd = (const bf16_t*)(ws + WS_GDN); v = bf2f(Gd[i % GDN_ARR]) + bf2f(Gd[GDN_ARR + i % GDN_ARR]) + bf2f(Gd[2 * GDN_ARR + i % GDN_ARR]) + bf2f(Gd[3 * GDN_ARR + i % GDN_ARR]) + bf2f(Gd[4 * GDN_ARR + i % GDN_ARR]); }
    else if (which == 5) v = bf2f(((const bf16_t*)(ws + WS_U))[i]);
    else if (which == 6) { v = bf2f(((const bf16_t*)(ws + WS_QB))[(t * 4 + (c >> 8)) * 96 + (c & 255) % 96]) + bf2f(((const bf16_t*)(ws + WS_KB))[(t * 4 + (c >> 8)) * 96 + (c & 255) % 96]) + bf2f(((const bf16_t*)(ws + WS_VT))[t * 256 + (c & 255)]);
        const bf16_t* Gd = (const bf16_t*)(ws + WS_GDN); v += bf2f(Gd[i % GDN_ARR]) + bf2f(Gd[GDN_ARR + i % GDN_ARR]) + bf2f(Gd[2 * GDN_ARR + i % GDN_ARR]) + bf2f(Gd[3 * GDN_ARR + i % GDN_ARR]) + bf2f(Gd[4 * GDN_ARR + i % GDN_ARR]);
        v += bf2f(((const bf16_t*)(ws + WS_U))[t * 1024 + 256 + (c & 511)]); }
    out[i] = v;
}
#endif
extern "C" void kernel_launch(void* const* d_in, const int* in_sizes, int n_in, void* d_out, int out_size, void* d_ws, size_t ws_size, hipStream_t stream) {
    static int grid = 0;
    if (grid == 0) {
        if (n_in != 27 || out_size != NT * ND || ws_size < WS_END) { fprintf(stderr, "kernel_launch: unexpected shapes (n_in %d out %d ws %zu)\n", n_in, out_size, ws_size); grid = -1; return; }
        int dev = 0, cus = 0, per_cu = 0;
        (void)hipGetDevice(&dev);
        (void)hipDeviceGetAttribute(&cus, hipDeviceAttributeMultiprocessorCount, dev);
        if (hipFuncSetAttribute((const void*)mk_fwd, hipFuncAttributeMaxDynamicSharedMemorySize, LDS_BYTES) != hipSuccess) { fprintf(stderr, "kernel_launch: hipFuncSetAttribute failed\n"); grid = -1; return; }
        if (hipOccupancyMaxActiveBlocksPerMultiprocessor(&per_cu, (const void*)mk_fwd, NTHREADS, LDS_BYTES) != hipSuccess || per_cu < 1) { fprintf(stderr, "kernel_launch: occupancy query says %d\n", per_cu); per_cu = 1; }
        (void)hipGetLastError();
        grid = cus;
    }
    if (grid < 0) return;
    if (hipMemsetAsync((char*)d_ws + WS_BAR, 0, XCD_BAR_WORDS * 4, stream) != hipSuccess) { fprintf(stderr, "kernel_launch: memset failed\n"); return; }
    KArgs a{};
    for (int i = 0; i < 27; ++i) a.in[i] = (const float*)d_in[i];
    a.out = (float*)d_out; a.ws = (unsigned char*)d_ws;
#ifdef DBG_STOP
    const int nl = DBG_STOP + 1;
#else
    const int nl = MK_N_LAUNCHES;
#endif
    for (int li = 0; li < nl; ++li) {
        a.ph_lo = (nl == 1) ? 0 : li; a.ph_hi = (nl == 1) ? N_PHASES : li + 1;
        void* args[] = {&a};
        hipError_t e = hipLaunchCooperativeKernel((const void*)mk_fwd, dim3(grid), dim3(NTHREADS), args, LDS_BYTES, stream);
        if (e != hipSuccess) { fprintf(stderr, "kernel_launch: cooperative launch failed: %s (grid %d)\n", hipGetErrorString(e), grid); break; }
    }
#if defined(DBG_DUMP) && DBG_DUMP == 7
    dbg_hash<<<2048, 256, 0, stream>>>((const unsigned char*)d_ws, (float*)d_out);
#elif defined(DBG_DUMP)
    dbg_dump<<<(NT * ND) / 256, 256, 0, stream>>>((const unsigned char*)d_ws, (float*)d_out, DBG_DUMP);
#endif
}
```
